# Optimizing an MI355X kernel written in HIP

```python
import math
import jax, jax.numpy as jnp
from jax import lax
import numpy as np

D_MODEL = 2048
BATCH = 2
SEQ = 4096
DEPTH = 4

N_EVEN = (DEPTH + 1) // 2
N_ODD = DEPTH // 2

S5_WIDTH = D_MODEL // 2
RWKV_WIDTH = D_MODEL - S5_WIDTH
S5_GROUP = 16
S5_GROUPS = S5_WIDTH // S5_GROUP
S5_STATE = 64
S5_DT_MIN = 0.001
S5_DT_MAX = 0.1
RWKV_HEAD = 64
RWKV_HEADS = RWKV_WIDTH // RWKV_HEAD
RWKV_W_RANK = 64
RWKV_A_RANK = 64
RWKV_G_RANK = 160
EVEN_IN = S5_WIDTH + 3 * RWKV_WIDTH + RWKV_W_RANK + RWKV_A_RANK + RWKV_G_RANK
SHIFT_COLS = EVEN_IN - S5_WIDTH
GN_EPS = 64e-5

LRU_WIDTH = D_MODEL
LRU_BLOCKS = 8
LRU_BLOCK = LRU_WIDTH // LRU_BLOCKS
CONV_WIDTH = 4
LRU_C = 8.0

D_FF = -(-8 * D_MODEL // (3 * 256)) * 256
NORM_EPS = 1e-6

kernel_name = "hybrid_s5_rwkv7_rglru_trunk"


def rms_norm(x, g):
    xf = x.astype(jnp.float32)
    y = xf * lax.rsqrt(jnp.mean(xf * xf, axis=-1, keepdims=True) + NORM_EPS)
    return (y * g.astype(jnp.float32)).astype(x.dtype)


def token_shift(z):
    return jnp.pad(z, ((0, 0), (1, 0), (0, 0)))[:, :-1]


def complex_linear_combine(e1, e2):
    a1r, a1i, b1r, b1i = e1
    a2r, a2i, b2r, b2i = e2
    ar = a1r * a2r - a1i * a2i
    ai = a1r * a2i + a1i * a2r
    br = a2r * b1r - a2i * b1i + b2r
    bi = a2r * b1i + a2i * b1r + b2i
    return ar, ai, br, bi


def real_linear_combine(e1, e2):
    a1, b1 = e1
    a2, b2 = e2
    return a1 * a2, a2 * b1 + b2


def s5_mixer(u, lam_re, lam_im, log_dt, b_re, b_im, c_re, c_im, d_skip, w_glu):
    f32 = jnp.float32
    bsz, t_len, _ = u.shape
    uf = u.astype(f32).reshape(bsz, t_len, S5_GROUPS, S5_GROUP)
    dt = jnp.exp(log_dt.astype(f32))[:, None]
    lr = lam_re.astype(f32)
    li = lam_im.astype(f32)
    mag = jnp.exp(lr * dt)
    abar_re = mag * jnp.cos(li * dt)
    abar_im = mag * jnp.sin(li * dt)
    den = lr * lr + li * li
    nr = abar_re - 1.0
    ni = abar_im
    gam_re = (nr * lr + ni * li) / den
    gam_im = (ni * lr - nr * li) / den
    br_ = b_re.astype(f32)
    bi_ = b_im.astype(f32)
    bb_re = gam_re[..., None] * br_ - gam_im[..., None] * bi_
    bb_im = gam_re[..., None] * bi_ + gam_im[..., None] * br_
    bu_re = jnp.einsum('btgc,gpc->tbgp', uf, bb_re)
    bu_im = jnp.einsum('btgc,gpc->tbgp', uf, bb_im)
    a_re = jnp.broadcast_to(abar_re, (t_len, 1, S5_GROUPS, S5_STATE))
    a_im = jnp.broadcast_to(abar_im, (t_len, 1, S5_GROUPS, S5_STATE))
    _, _, s_re, s_im = lax.associative_scan(
        complex_linear_combine, (a_re, a_im, bu_re, bu_im), axis=0)
    y = (jnp.einsum('tbgp,gcp->btgc', s_re, c_re.astype(f32))
         - jnp.einsum('tbgp,gcp->btgc', s_im, c_im.astype(f32)))
    y = y + d_skip.astype(f32).reshape(S5_GROUPS, S5_GROUP) * uf
    y = jax.nn.gelu(y.reshape(bsz, t_len, S5_WIDTH)).astype(u.dtype)
    return y * jax.nn.sigmoid(y @ w_glu)


def rwkv7_mixer(r, k, v, w_lr, a_lr, g_lr, w0, w2, a0, a2, g2, k_k, k_a, r_k,
                lnx_w, lnx_b):
    f32 = jnp.float32
    bsz, t_len, _ = r.shape
    r, k, v = r.astype(f32), k.astype(f32), v.astype(f32)
    w = -jax.nn.softplus(-(w0.astype(f32) + jnp.tanh(w_lr.astype(f32)) @ w2.astype(f32))) - 0.5
    decay = jnp.exp(-jnp.exp(w))
    a = jax.nn.sigmoid(a0.astype(f32) + a_lr.astype(f32) @ a2.astype(f32))
    g = jax.nn.sigmoid(g_lr.astype(f32)) @ g2.astype(f32)
    hs = (bsz, t_len, RWKV_HEADS, RWKV_HEAD)
    kk = (k * k_k.astype(f32)).reshape(hs)
    kk = kk * lax.rsqrt(jnp.maximum(jnp.sum(kk * kk, -1, keepdims=True), 1e-24))
    k = k * (1.0 + (a - 1.0) * k_a.astype(f32))
    rh, kh, vh = r.reshape(hs), k.reshape(hs), v.reshape(hs)
    ah = a.reshape(hs)
    wh = decay.reshape(hs)
    vec_a = -kk
    vec_b = kk * ah
    tf = lambda z: jnp.swapaxes(z, 0, 1)

    def step(state, inp):
        r_t, w_t, k_t, v_t, a_t, b_t = inp
        sa = jnp.einsum('bhvk,bhk->bhv', state, a_t)
        state = (state * w_t[:, :, None, :]
                 + sa[..., None] * b_t[:, :, None, :]
                 + v_t[..., None] * k_t[:, :, None, :])
        return state, jnp.einsum('bhvk,bhk->bhv', state, r_t)

    s0 = jnp.zeros((bsz, RWKV_HEADS, RWKV_HEAD, RWKV_HEAD), f32)
    _, y = lax.scan(step, s0, (tf(rh), tf(wh), tf(kh), tf(vh), tf(vec_a), tf(vec_b)))
    y = tf(y)
    mu = jnp.mean(y, -1, keepdims=True)
    var = jnp.mean(jnp.square(y - mu), -1, keepdims=True)
    y = (y - mu) * lax.rsqrt(var + GN_EPS)
    y = y * lnx_w.astype(f32).reshape(RWKV_HEADS, RWKV_HEAD) + lnx_b.astype(f32).reshape(RWKV_HEADS, RWKV_HEAD)
    bonus = jnp.sum(rh * kh * r_k.astype(f32), -1, keepdims=True) * vh
    y = (y + bonus).reshape(bsz, t_len, RWKV_WIDTH)
    return y * g


def even_mixer(h, w_in, shift_mu, s5_lam_re, s5_lam_im, s5_log_dt, s5_b_re, s5_b_im,
               s5_c_re, s5_c_im, s5_d, s5_w_glu, rw_w0, rw_w2, rw_a0, rw_a2, rw_g2,
               rw_k_k, rw_k_a, rw_r_k, rw_lnx_w, rw_lnx_b, w_out):
    p = h @ w_in
    u = p[..., :S5_WIDTH]
    z = p[..., S5_WIDTH:]
    z = z + (token_shift(z) - z) * shift_mu
    o = 0
    r = z[..., o:o + RWKV_WIDTH]; o += RWKV_WIDTH
    k = z[..., o:o + RWKV_WIDTH]; o += RWKV_WIDTH
    v = z[..., o:o + RWKV_WIDTH]; o += RWKV_WIDTH
    w_lr = z[..., o:o + RWKV_W_RANK]; o += RWKV_W_RANK
    a_lr = z[..., o:o + RWKV_A_RANK]; o += RWKV_A_RANK
    g_lr = z[..., o:o + RWKV_G_RANK]
    y_s5 = s5_mixer(u, s5_lam_re, s5_lam_im, s5_log_dt, s5_b_re, s5_b_im,
                    s5_c_re, s5_c_im, s5_d, s5_w_glu)
    y_rw = rwkv7_mixer(r, k, v, w_lr, a_lr, g_lr, rw_w0, rw_w2, rw_a0, rw_a2, rw_g2,
                       rw_k_k, rw_k_a, rw_r_k, rw_lnx_w, rw_lnx_b)
    y = jnp.concatenate([y_s5, y_rw.astype(h.dtype)], axis=-1)
    return y @ w_out


def odd_mixer(h, w_in, conv_w, conv_b, w_r, b_r, w_i, b_i, lam, w_out):
    f32 = jnp.float32
    bsz, t_len, _ = h.shape
    p = h @ w_in
    gate = jax.nn.gelu(p[..., :LRU_WIDTH])
    xb = p[..., LRU_WIDTH:]
    xc = lax.conv_general_dilated(
        xb, conv_w.astype(xb.dtype)[:, None, :], window_strides=(1,),
        padding=[(CONV_WIDTH - 1, 0)], dimension_numbers=('NWC', 'WIO', 'NWC'),
        feature_group_count=LRU_WIDTH) + conv_b
    xf = xc.astype(f32)
    xblk = xf.reshape(bsz, t_len, LRU_BLOCKS, LRU_BLOCK)
    gr = (jnp.einsum('btnc,ncd->btnd', xblk, w_r.astype(f32)).reshape(bsz, t_len, LRU_WIDTH)
          + b_r.astype(f32))
    gi = (jnp.einsum('btnc,ncd->btnd', xblk, w_i.astype(f32)).reshape(bsz, t_len, LRU_WIDTH)
          + b_i.astype(f32))
    log_a = -LRU_C * jax.nn.sigmoid(gr) * jax.nn.softplus(-lam.astype(f32))
    a = jnp.exp(log_a)
    mult = jnp.sqrt(-jnp.expm1(2.0 * log_a))
    bx = mult * jax.nn.sigmoid(gi) * xf
    _, hseq = lax.associative_scan(real_linear_combine, (a, bx), axis=1)
    return (hseq.astype(h.dtype) * gate) @ w_out


def swiglu(h, w_gate, w_up, w_down):
    return (jax.nn.silu(h @ w_gate) * (h @ w_up)) @ w_down


def setup_inputs(seed: int = 0) -> dict:
    key = jax.random.key(seed)
    ks = iter(jax.random.split(key, 48))
    nrm = lambda shape, s: jax.random.normal(next(ks), shape, jnp.float32) * s
    uni = lambda shape, lo, hi: jax.random.uniform(next(ks), shape, jnp.float32, lo, hi)
    E, O = N_EVEN, N_ODD
    G, P, C = S5_GROUPS, S5_STATE, S5_GROUP
    a8 = uni((O, LRU_WIDTH), 0.9, 0.999)
    a_base = a8 ** (1.0 / LRU_C)
    return {
        "x": nrm((BATCH, SEQ, D_MODEL), 1.0),
        "ev_w_in": nrm((E, D_MODEL, EVEN_IN), D_MODEL ** -0.5),
        "ev_shift_mu": uni((E, SHIFT_COLS), 0.0, 1.0),
        "s5_lam_re": -0.5 + nrm((E, G, P), 0.01),
        "s5_lam_im": math.pi * jnp.arange(P, dtype=jnp.float32) + nrm((E, G, P), 0.01),
        "s5_log_dt": uni((E, G), math.log(S5_DT_MIN), math.log(S5_DT_MAX)),
        "s5_b_re": nrm((E, G, P, C), (2.0 * C) ** -0.5),
        "s5_b_im": nrm((E, G, P, C), (2.0 * C) ** -0.5),
        "s5_c_re": nrm((E, G, C, P), (2.0 * P) ** -0.5),
        "s5_c_im": nrm((E, G, C, P), (2.0 * P) ** -0.5),
        "s5_d": nrm((E, S5_WIDTH), 1.0),
        "s5_w_glu": nrm((E, S5_WIDTH, S5_WIDTH), S5_WIDTH ** -0.5),
        "rw_w0": uni((E, RWKV_WIDTH), -5.0, 1.0),
        "rw_w2": nrm((E, RWKV_W_RANK, RWKV_WIDTH), 0.1),
        "rw_a0": nrm((E, RWKV_WIDTH), 0.1),
        "rw_a2": nrm((E, RWKV_A_RANK, RWKV_WIDTH), 0.5 * RWKV_A_RANK ** -0.5),
        "rw_g2": nrm((E, RWKV_G_RANK, RWKV_WIDTH), RWKV_G_RANK ** -0.5),
        "rw_k_k": 0.85 + nrm((E, RWKV_WIDTH), 0.02),
        "rw_k_a": 1.0 + nrm((E, RWKV_WIDTH), 0.02),
        "rw_r_k": nrm((E, RWKV_HEADS, RWKV_HEAD), 0.1),
        "rw_lnx_w": 1.0 + nrm((E, RWKV_WIDTH), 0.02),
        "rw_lnx_b": nrm((E, RWKV_WIDTH), 0.01),
        "ev_w_out": nrm((E, D_MODEL, D_MODEL), D_MODEL ** -0.5),
        "od_w_in": nrm((O, D_MODEL, 2 * LRU_WIDTH), D_MODEL ** -0.5),
        "od_conv_w": nrm((O, CONV_WIDTH, LRU_WIDTH), CONV_WIDTH ** -0.5),
        "od_conv_b": nrm((O, LRU_WIDTH), 0.01),
        "lru_w_r": nrm((O, LRU_BLOCKS, LRU_BLOCK, LRU_BLOCK), LRU_BLOCK ** -0.5),
        "lru_b_r": nrm((O, LRU_WIDTH), 0.01),
        "lru_w_i": nrm((O, LRU_BLOCKS, LRU_BLOCK, LRU_BLOCK), LRU_BLOCK ** -0.5),
        "lru_b_i": nrm((O, LRU_WIDTH), 0.01),
        "lru_lam": jnp.log(a_base) - jnp.log1p(-a_base),
        "od_w_out": nrm((O, LRU_WIDTH, D_MODEL), LRU_WIDTH ** -0.5),
        "ffn_w_gate": nrm((DEPTH, D_MODEL, D_FF), D_MODEL ** -0.5),
        "ffn_w_up": nrm((DEPTH, D_MODEL, D_FF), D_MODEL ** -0.5),
        "ffn_w_down": nrm((DEPTH, D_FF, D_MODEL), D_FF ** -0.5),
        "norm_mix_pre": 1.0 + nrm((DEPTH, D_MODEL), 0.02),
        "norm_mix_post": 1.0 + nrm((DEPTH, D_MODEL), 0.02),
        "norm_ffn_pre": 1.0 + nrm((DEPTH, D_MODEL), 0.02),
        "norm_ffn_post": 1.0 + nrm((DEPTH, D_MODEL), 0.02),
    }


def reference(x, ev_w_in, ev_shift_mu, s5_lam_re, s5_lam_im, s5_log_dt, s5_b_re, s5_b_im,
              s5_c_re, s5_c_im, s5_d, s5_w_glu, rw_w0, rw_w2, rw_a0, rw_a2, rw_g2,
              rw_k_k, rw_k_a, rw_r_k, rw_lnx_w, rw_lnx_b, ev_w_out,
              od_w_in, od_conv_w, od_conv_b, lru_w_r, lru_b_r, lru_w_i, lru_b_i, lru_lam,
              od_w_out, ffn_w_gate, ffn_w_up, ffn_w_down,
              norm_mix_pre, norm_mix_post, norm_ffn_pre, norm_ffn_post):
    for layer in range(DEPTH):
        i = layer // 2
        h = rms_norm(x, norm_mix_pre[layer])
        if layer % 2 == 0:
            y = even_mixer(h, ev_w_in[i], ev_shift_mu[i], s5_lam_re[i], s5_lam_im[i],
                           s5_log_dt[i], s5_b_re[i], s5_b_im[i], s5_c_re[i], s5_c_im[i],
                           s5_d[i], s5_w_glu[i], rw_w0[i], rw_w2[i], rw_a0[i], rw_a2[i],
                           rw_g2[i], rw_k_k[i], rw_k_a[i], rw_r_k[i], rw_lnx_w[i],
                           rw_lnx_b[i], ev_w_out[i])
        else:
            y = odd_mixer(h, od_w_in[i], od_conv_w[i], od_conv_b[i], lru_w_r[i], lru_b_r[i],
                          lru_w_i[i], lru_b_i[i], lru_lam[i], od_w_out[i])
        x = x + rms_norm(y.astype(x.dtype), norm_mix_post[layer])
        h = rms_norm(x, norm_ffn_pre[layer])
        y = swiglu(h, ffn_w_gate[layer], ffn_w_up[layer], ffn_w_down[layer])
        x = x + rms_norm(y, norm_ffn_post[layer])
    return x
```

```cpp
#include <hip/hip_runtime.h>
#include <hip/hip_cooperative_groups.h>
#include <cstdio>
namespace cg = cooperative_groups;

#define LAS __attribute__((address_space(3)))
typedef unsigned short bf16_t;
typedef short bf16x8 __attribute__((ext_vector_type(8)));
typedef float f32x4 __attribute__((ext_vector_type(4)));
typedef unsigned u32x4 __attribute__((ext_vector_type(4)));
typedef unsigned u32x2 __attribute__((ext_vector_type(2)));

constexpr int MTOK = 8192, TSEQ = 4096, DM = 2048, DFF = 5632;
constexpr int EVIN_N = 4384, EVIN_NP = 4608, LRK = 384;
constexpr int NTHREADS = 512, NWAVES = 8;
constexpr int BM = 256, BK = 64, HALF = 128, HTB = HALF * BK * 2, STAGE_BYTES = 8 * HTB, NXCD = 8, WGM = 8;
constexpr int LDS_BYTES = STAGE_BYTES;

constexpr size_t al256(size_t x) { return (x + 255) & ~(size_t)255; }
constexpr size_t SZ_EVIN = (size_t)EVIN_NP * DM * 2, SZ_GLU = (size_t)1024 * 1024 * 2, SZ_LR = (size_t)3072 * LRK * 2, SZ_SQ = (size_t)DM * DM * 2;
constexpr size_t SZ_ODIN = (size_t)4096 * DM * 2, SZ_GATES = (size_t)4096 * 256 * 2, SZ_GU = (size_t)2 * DFF * DM * 2, SZ_DN = (size_t)DM * DFF * 2;
constexpr size_t WS_EVIN = 0;
constexpr size_t WS_GLU = WS_EVIN + 2 * SZ_EVIN;
constexpr size_t WS_LR = WS_GLU + 2 * SZ_GLU;
constexpr size_t WS_EVOUT = WS_LR + 2 * SZ_LR;
constexpr size_t WS_ODIN = WS_EVOUT + 2 * SZ_SQ;
constexpr size_t WS_GATES = WS_ODIN + 2 * SZ_ODIN;
constexpr size_t WS_ODOUT = WS_GATES + 2 * SZ_GATES;
constexpr size_t WS_GU = WS_ODOUT + 2 * SZ_SQ;
constexpr size_t WS_DN = WS_GU + 4 * SZ_GU;
constexpr size_t WS_H = WS_DN + 4 * SZ_DN;
constexpr size_t WS_P = WS_H + (size_t)MTOK * DM * 2;
constexpr size_t WS_YMIX = WS_P + (size_t)MTOK * EVIN_NP * 2;
constexpr size_t WS_ACT = WS_YMIX + (size_t)MTOK * DM * 4;
constexpr size_t WS_MIX2 = WS_ACT + (size_t)MTOK * DFF * 2;
constexpr size_t WS_END = WS_MIX2 + (size_t)MTOK * DM * 4;
constexpr size_t WS_LRACT = WS_ACT;
constexpr size_t WS_DEC = WS_LRACT + (size_t)MTOK * LRK * 2;
constexpr size_t WS_AB = WS_DEC + (size_t)MTOK * 1024 * 4;
constexpr size_t WS_GB = WS_AB + (size_t)MTOK * 1024 * 2;
constexpr size_t WS_Y5 = WS_GB + (size_t)MTOK * 1024 * 2;
static_assert(WS_Y5 + (size_t)MTOK * 1024 * 2 <= WS_MIX2, "even temporaries overflow ACT");
constexpr size_t WS_YRAW = WS_MIX2;
constexpr size_t WS_YCAT = WS_MIX2 + (size_t)MTOK * 1024 * 4;
constexpr size_t WS_GATE = WS_P;
constexpr size_t WS_XB = WS_P + (size_t)MTOK * DM * 2;
constexpr size_t WS_XC = WS_YMIX;
constexpr size_t WS_AA = WS_ACT;
constexpr size_t WS_BX = WS_MIX2;

struct Params { const float* in[39]; float* out; unsigned char* ws; };

__device__ __forceinline__ unsigned cvt_pk_bf16(float lo, float hi) { unsigned r; asm volatile("v_cvt_pk_bf16_f32 %0, %1, %2" : "=v"(r) : "v"(lo), "v"(hi)); return r; }
__device__ __forceinline__ float bflo(unsigned w) { return __uint_as_float(w << 16); }
__device__ __forceinline__ float bfhi(unsigned w) { return __uint_as_float(w & 0xffff0000u); }
__device__ __forceinline__ float sigm(float x) { return __builtin_amdgcn_rcpf(1.0f + __expf(-x)); }
__device__ __forceinline__ float gelu_t(float x) { return x * sigm(1.5957691216057308f * (x + 0.044715f * x * x * x)); }
__device__ __forceinline__ float softplus_f(float z) { return fmaxf(z, 0.f) + __logf(1.0f + __expf(-fabsf(z))); }
__device__ __forceinline__ void unpack8(const u32x4 w, float (&f)[8]) {
    f[0] = bflo(w.x); f[1] = bfhi(w.x); f[2] = bflo(w.y); f[3] = bfhi(w.y); f[4] = bflo(w.z); f[5] = bfhi(w.z); f[6] = bflo(w.w); f[7] = bfhi(w.w);
}
__device__ __forceinline__ u32x4 pack8(const float (&f)[8]) { u32x4 w; w.x = cvt_pk_bf16(f[0], f[1]); w.y = cvt_pk_bf16(f[2], f[3]); w.z = cvt_pk_bf16(f[4], f[5]); w.w = cvt_pk_bf16(f[6], f[7]); return w; }
__device__ __forceinline__ float wave_sum(float v) {
#pragma unroll
    for (int o = 1; o < 64; o <<= 1) v += __shfl_xor(v, o);
    return v;
}
template <int CTRL> __device__ __forceinline__ float dpp_f(float x) { return __int_as_float(__builtin_amdgcn_update_dpp(0, __float_as_int(x), CTRL, 0xf, 0xf, true)); }
__device__ __forceinline__ float row16_sum(float x) {
    x += dpp_f<0xB1>(x);
    x += dpp_f<0x4E>(x);
    x += dpp_f<0x141>(x);
    x += dpp_f<0x140>(x);
    return x;
}
#define LDS_WAIT() asm volatile("s_waitcnt lgkmcnt(0)" ::: "memory")

__device__ __forceinline__ int lds_byte(int r, int c) { const int st = (r >> 4) * 2 + (c >> 5), rr = r & 15, cc = c & 31, ob = rr * 64 + cc * 2; return st * 1024 + (ob ^ (((ob >> 9) & 1) << 5)); }
__device__ __forceinline__ void stage_rc(int b, int& R, int& C) { const int st = b / 1024, sb = b % 1024, swz = sb ^ (((sb >> 9) & 1) << 5); R = (st >> 1) * 16 + swz / 64; C = (st & 1) * 32 + (swz % 64) / 2; }
__device__ __forceinline__ int perm32(int rho) { const int n = rho >> 4, i = rho & 15; return 8 * (i >> 2) + 4 * n + (i & 3); }

struct Unit { int pm, pn; };
struct Gemm { const bf16_t* A; const bf16_t* Bt; int lda, K, apn_shift, apn_mul; };
struct StaticOrder {
    int nM, nN, nwg, G, c;
    __device__ void init(int M, int N, int G_, int c_) { nM = M / BM; nN = N / BM; nwg = nM * nN; G = G_; c = c_; }
    __device__ bool next(int i, Unit& u) const {
        const long L = (long)i * G + c; if (L >= nwg) return false;
        int wgid = (int)L; { const int q = nwg / NXCD, r = nwg % NXCD, xcd = wgid % NXCD, off = wgid / NXCD; wgid = (xcd < r ? xcd * (q + 1) : r * (q + 1) + (xcd - r) * q) + off; }
        const int nig = WGM * nN, gid = wgid / nig, fm = gid * WGM, gsz = (nM - fm) < WGM ? (nM - fm) : WGM;
        u.pm = fm + ((wgid % nig) % gsz); u.pn = (wgid % nig) / gsz; return true;
    }
};

struct EpiF32 {
    static constexpr bool PERM = false;
    float* C; int ldc;
    __device__ __forceinline__ void operator()(const f32x4 (&acc)[2][2][4][2], const Unit& u, int wr, int wc, int fr, int fq) const {
        const int row0 = u.pm * BM + wr * 64 + fr, col0 = u.pn * BM + wc * 32 + 4 * fq;
#pragma unroll
        for (int ai = 0; ai < 2; ++ai)
#pragma unroll
            for (int m = 0; m < 4; ++m) { float* rowp = C + (size_t)(row0 + ai * HALF + m * 16) * ldc + col0;
#pragma unroll
                for (int bj = 0; bj < 2; ++bj)
#pragma unroll
                    for (int n = 0; n < 2; ++n) *(f32x4*)(rowp + bj * HALF + n * 16) = acc[ai][bj][m][n]; }
    }
};
struct EpiBf16 {
    static constexpr bool PERM = true;
    bf16_t* O; int ldc;
    __device__ __forceinline__ void operator()(const f32x4 (&acc)[2][2][4][2], const Unit& u, int wr, int wc, int fr, int fq) const {
        const int row0 = u.pm * BM + wr * 64 + fr, col0 = u.pn * BM + wc * 32 + 8 * fq;
#pragma unroll
        for (int ai = 0; ai < 2; ++ai)
#pragma unroll
            for (int m = 0; m < 4; ++m) { bf16_t* rowp = O + (size_t)(row0 + ai * HALF + m * 16) * ldc + col0;
#pragma unroll
                for (int bj = 0; bj < 2; ++bj) { const f32x4 v0 = acc[ai][bj][m][0], v1 = acc[ai][bj][m][1];
                    u32x4 w; w.x = cvt_pk_bf16(v0[0], v0[1]); w.y = cvt_pk_bf16(v0[2], v0[3]); w.z = cvt_pk_bf16(v1[0], v1[1]); w.w = cvt_pk_bf16(v1[2], v1[3]);
                    *(u32x4*)(rowp + bj * HALF) = w; } }
    }
};
struct EpiOddIn {
    static constexpr bool PERM = true;
    bf16_t* GATE; bf16_t* XB;
    __device__ __forceinline__ void operator()(const f32x4 (&acc)[2][2][4][2], const Unit& u, int wr, int wc, int fr, int fq) const {
        const bool isg = u.pn < 8; bf16_t* base = isg ? GATE : XB;
        const int row0 = u.pm * BM + wr * 64 + fr, col0 = (u.pn & 7) * BM + wc * 32 + 8 * fq;
#pragma unroll
        for (int ai = 0; ai < 2; ++ai)
#pragma unroll
            for (int m = 0; m < 4; ++m) { bf16_t* rowp = base + (size_t)(row0 + ai * HALF + m * 16) * DM + col0;
#pragma unroll
                for (int bj = 0; bj < 2; ++bj) { f32x4 v0 = acc[ai][bj][m][0], v1 = acc[ai][bj][m][1];
                    if (isg) {
#pragma unroll
                        for (int j = 0; j < 4; ++j) { v0[j] = gelu_t(v0[j]); v1[j] = gelu_t(v1[j]); } }
                    u32x4 w; w.x = cvt_pk_bf16(v0[0], v0[1]); w.y = cvt_pk_bf16(v0[2], v0[3]); w.z = cvt_pk_bf16(v1[0], v1[1]); w.w = cvt_pk_bf16(v1[2], v1[3]);
                    *(u32x4*)(rowp + bj * HALF) = w; } }
    }
};
struct EpiLR {
    static constexpr bool PERM = true;
    float* DEC; bf16_t* AB; bf16_t* GB; const float* w0; const float* a0;
    __device__ __forceinline__ void operator()(const f32x4 (&acc)[2][2][4][2], const Unit& u, int wr, int wc, int fr, int fq) const {
        const int type = u.pn >> 2;
        bf16_t* obase = AB; if (type == 2) obase = GB;
        const int row0 = u.pm * BM + wr * 64 + fr, col0 = (u.pn & 3) * BM + wc * 32 + 8 * fq;
#pragma unroll
        for (int bj = 0; bj < 2; ++bj) {
            const int col = col0 + bj * HALF;
            f32x4 c0 = (f32x4){0.f, 0.f, 0.f, 0.f}, c1 = c0;
            if (type == 0) { c0 = *(const f32x4*)(w0 + col); c1 = *(const f32x4*)(w0 + col + 4); }
            else if (type == 1) { c0 = *(const f32x4*)(a0 + col); c1 = *(const f32x4*)(a0 + col + 4); }
#pragma unroll
            for (int ai = 0; ai < 2; ++ai)
#pragma unroll
                for (int m = 0; m < 4; ++m) {
                    const size_t off = (size_t)(row0 + ai * HALF + m * 16) * 1024 + col;
                    f32x4 v0 = acc[ai][bj][m][0] + c0, v1 = acc[ai][bj][m][1] + c1;
                    if (type == 0) {
#pragma unroll
                        for (int j = 0; j < 4; ++j) { v0[j] = __expf(-__expf(-softplus_f(-v0[j]) - 0.5f)); v1[j] = __expf(-__expf(-softplus_f(-v1[j]) - 0.5f)); }
                        *(f32x4*)(DEC + off) = v0; *(f32x4*)(DEC + off + 4) = v1;
                    } else {
                        if (type == 1) {
#pragma unroll
                            for (int j = 0; j < 4; ++j) { v0[j] = sigm(v0[j]); v1[j] = sigm(v1[j]); } }
                        u32x4 w; w.x = cvt_pk_bf16(v0[0], v0[1]); w.y = cvt_pk_bf16(v0[2], v0[3]); w.z = cvt_pk_bf16(v1[0], v1[1]); w.w = cvt_pk_bf16(v1[2], v1[3]);
                        *(u32x4*)(obase + off) = w;
                    }
                }
        }
    }
};
struct EpiGLU {
    static constexpr bool PERM = true;
    const bf16_t* Y5; bf16_t* YCAT;
    __device__ __forceinline__ void operator()(const f32x4 (&acc)[2][2][4][2], const Unit& u, int wr, int wc, int fr, int fq) const {
        const int row0 = u.pm * BM + wr * 64 + fr, col0 = u.pn * BM + wc * 32 + 8 * fq;
#pragma unroll
        for (int ai = 0; ai < 2; ++ai)
#pragma unroll
            for (int m = 0; m < 4; ++m) { const int row = row0 + ai * HALF + m * 16;
#pragma unroll
                for (int bj = 0; bj < 2; ++bj) { const f32x4 v0 = acc[ai][bj][m][0], v1 = acc[ai][bj][m][1];
                    const u32x4 yw = *(const u32x4*)(Y5 + (size_t)row * 1024 + col0 + bj * HALF);
                    float y[8]; unpack8(yw, y);
                    float o[8];
#pragma unroll
                    for (int j = 0; j < 4; ++j) { o[j] = y[j] * sigm(v0[j]); o[4 + j] = y[4 + j] * sigm(v1[j]); }
                    *(u32x4*)(YCAT + (size_t)row * DM + col0 + bj * HALF) = pack8(o); } }
    }
};
struct EpiGates {
    static constexpr bool PERM = true;
    const bf16_t* XC; float* AA; float* BX; const float* b_r; const float* b_i; const float* lam;
    __device__ __forceinline__ void operator()(const f32x4 (&acc)[2][2][4][2], const Unit& u, int wr, int wc, int fr, int fq) const {
        const int row0 = u.pm * BM + wr * 64 + fr, ch0 = (u.pn >> 1) * 256 + (u.pn & 1) * 128 + wc * 32 + 8 * fq;
#pragma unroll
        for (int ai = 0; ai < 2; ++ai)
#pragma unroll
            for (int m = 0; m < 4; ++m) { const int row = row0 + ai * HALF + m * 16; const size_t off = (size_t)row * DM + ch0;
                const u32x4 xw = *(const u32x4*)(XC + off); float xc[8]; unpack8(xw, xc);
#pragma unroll
                for (int n = 0; n < 2; ++n) {
                    const f32x4 br = *(const f32x4*)(b_r + ch0 + 4 * n), bi = *(const f32x4*)(b_i + ch0 + 4 * n), lm = *(const f32x4*)(lam + ch0 + 4 * n);
                    f32x4 av, bv;
#pragma unroll
                    for (int j = 0; j < 4; ++j) {
                        const float gr = acc[ai][0][m][n][j] + br[j], gi = acc[ai][1][m][n][j] + bi[j];
                        const float la = -8.0f * sigm(gr) * softplus_f(-lm[j]);
                        const float a = __expf(la);
                        const float mult = sqrtf(fmaxf(1.0f - __expf(2.0f * la), 0.f));
                        av[j] = a; bv[j] = mult * sigm(gi) * xc[4 * n + j];
                    }
                    *(f32x4*)(AA + off + 4 * n) = av; *(f32x4*)(BX + off + 4 * n) = bv;
                } }
    }
};
struct EpiGU {
    static constexpr bool PERM = true;
    bf16_t* ACT;
    __device__ __forceinline__ void operator()(const f32x4 (&acc)[2][2][4][2], const Unit& u, int wr, int wc, int fr, int fq) const {
        const int row0 = u.pm * BM + wr * 64 + fr, col0 = u.pn * HALF + wc * 32 + 8 * fq;
#pragma unroll
        for (int ai = 0; ai < 2; ++ai)
#pragma unroll
            for (int m = 0; m < 4; ++m) { const int row = row0 + ai * HALF + m * 16;
                float o[8];
#pragma unroll
                for (int n = 0; n < 2; ++n)
#pragma unroll
                    for (int j = 0; j < 4; ++j) { const float g = acc[ai][0][m][n][j]; o[4 * n + j] = g * sigm(g) * acc[ai][1][m][n][j]; }
                *(u32x4*)(ACT + (size_t)row * DFF + col0) = pack8(o); }
    }
};

template <class Epi>
__device__ __forceinline__ void gemm_phase(LAS unsigned char* lds, const Gemm g, const StaticOrder& S, const Epi& E, int tid  ) {
    const int wid = __builtin_amdgcn_readfirstlane(tid >> 6), lane = tid & 63, wr = wid >> 2, wc = wid & 3, fr = lane & 15, fq = lane >> 4;
    const int K = g.K, nt = K / BK;
    unsigned voffA[2], voffB[2];
#pragma unroll
    for (int i = 0; i < 2; ++i) { int R, C; stage_rc(tid * 16 + i * 8192, R, C); const int Rb = Epi::PERM ? ((R & ~31) + perm32(R & 31)) : R;
        voffA[i] = (unsigned)(R * g.lda + C) * 2u; voffB[i] = (unsigned)(Rb * K + C) * 2u; }
    const size_t kstep = (size_t)(BK * 2);
    const size_t hstepA = (size_t)HALF * g.lda * 2, hstepB = (size_t)HALF * K * 2;
    const size_t tstepA = 2 * hstepA, tstepB = 2 * hstepB;
    const unsigned ldsw = (unsigned)wid * 1024u;
    const int aoff = lds_byte(wr * 64 + fr, fq * 8), boff = lds_byte(wc * 32 + fr, fq * 8);
#define PG8_SA(b, h) (((b) * 2 + (h)) * HTB)
#define PG8_SB(b, h) ((4 + (b) * 2 + (h)) * HTB)
#define PG8_STAGE(bufoff, gbase, voff) do { _Pragma("unroll") for (int _i = 0; _i < 2; ++_i) \
        __builtin_amdgcn_global_load_lds((const unsigned*)((const char*)(gbase) + (voff)[_i]), (LAS unsigned*)(lds + (bufoff) + ldsw + _i * 8192), 16, 0, 0); } while (0)
#define PG8_LDA(dst, b, h) do { _Pragma("unroll") for (int m = 0; m < 4; ++m) _Pragma("unroll") for (int k = 0; k < 2; ++k) dst[m][k] = *(const LAS bf16x8*)(lds + PG8_SA(b, h) + aoff + m * 2048 + k * 1024); } while (0)
#define PG8_LDB(dst, b, h) do { _Pragma("unroll") for (int n = 0; n < 2; ++n) _Pragma("unroll") for (int k = 0; k < 2; ++k) dst[n][k] = *(const LAS bf16x8*)(lds + PG8_SB(b, h) + boff + n * 2048 + k * 1024); } while (0)
#define PG8_MMA(ai, bj, At, Bt) do { __builtin_amdgcn_s_setprio(1); _Pragma("unroll") for (int m = 0; m < 4; ++m) _Pragma("unroll") for (int n = 0; n < 2; ++n) _Pragma("unroll") for (int k = 0; k < 2; ++k) \
        acc[ai][bj][m][n] = __builtin_amdgcn_mfma_f32_16x16x32_bf16(Bt[n][k], At[m][k], acc[ai][bj][m][n], 0, 0, 0); __builtin_amdgcn_s_setprio(0); } while (0)
#define PG8_WAIT_V(n) asm volatile("s_waitcnt vmcnt(" #n ")" ::: "memory")
#define PG8_WAIT_L(n) asm volatile("s_waitcnt lgkmcnt(" #n ")" ::: "memory")
#define PG8_BAR __builtin_amdgcn_s_barrier()
#define PG8_SCHED __builtin_amdgcn_sched_barrier(0)
#define PG8_AOF(u) ((const char*)g.A + (size_t)(u).pm * tstepA + (size_t)(((u).pn >> g.apn_shift) * g.apn_mul) * 2)
#define PG8_BOF(u) ((const char*)g.Bt + (size_t)(u).pn * tstepB)
    Unit cur, nxt; int ui = 0;
    if (!S.next(0, cur)) return;
    f32x4 acc[2][2][4][2];
#pragma unroll
    for (int a = 0; a < 2; ++a)
#pragma unroll
        for (int b = 0; b < 2; ++b)
#pragma unroll
            for (int m = 0; m < 4; ++m)
#pragma unroll
                for (int n = 0; n < 2; ++n) acc[a][b][m][n] = (f32x4){0.f, 0.f, 0.f, 0.f};
    bf16x8 At[4][2], B0[2][2], B1[2][2];
    const char* cA = PG8_AOF(cur); const char* cB = PG8_BOF(cur);
    PG8_STAGE(PG8_SB(0, 0), cB, voffB); PG8_STAGE(PG8_SA(0, 0), cA, voffA); PG8_STAGE(PG8_SB(0, 1), cB + hstepB, voffB); PG8_STAGE(PG8_SA(0, 1), cA + hstepA, voffA);
    if (wr == 1) PG8_BAR;
    PG8_WAIT_V(4); PG8_BAR;
    PG8_STAGE(PG8_SB(1, 0), cB + kstep, voffB); PG8_STAGE(PG8_SA(1, 0), cA + kstep, voffA); PG8_STAGE(PG8_SB(1, 1), cB + hstepB + kstep, voffB);
    PG8_WAIT_V(6); PG8_BAR;
    for (;;) {
        const bool has_next = S.next(ui + 1, nxt);
        const char* nA = has_next ? PG8_AOF(nxt) : cA; const char* nB = has_next ? PG8_BOF(nxt) : cB;
        for (int t = 0; t < nt; t += 2) {
            const bool last = (t == nt - 2);
            const char* a1 = cA + (size_t)(t + 1) * kstep;
            const char* a2 = last ? nA : cA + (size_t)(t + 2) * kstep; const char* b2 = last ? nB : cB + (size_t)(t + 2) * kstep;
            const char* a3 = a2 + kstep; const char* b3 = b2 + kstep;
            PG8_LDB(B0, 0, 0); PG8_SCHED; PG8_LDA(At, 0, 0); PG8_STAGE(PG8_SA(1, 1), a1 + hstepA, voffA);
            PG8_WAIT_L(8); PG8_BAR; PG8_WAIT_L(0); PG8_MMA(0, 0, At, B0); PG8_BAR; PG8_SCHED;
            PG8_LDB(B1, 0, 1); PG8_STAGE(PG8_SB(0, 0), b2, voffB);
            PG8_BAR; PG8_WAIT_L(0); PG8_MMA(0, 1, At, B1); PG8_BAR;
            PG8_LDA(At, 0, 1); PG8_STAGE(PG8_SA(0, 0), a2, voffA);
            PG8_BAR; PG8_WAIT_L(0); PG8_MMA(1, 0, At, B0); PG8_BAR; PG8_SCHED;
            PG8_STAGE(PG8_SB(0, 1), b2 + hstepB, voffB);
            PG8_WAIT_V(6); PG8_BAR; PG8_MMA(1, 1, At, B1); PG8_BAR;
            PG8_LDB(B0, 1, 0); PG8_SCHED; PG8_LDA(At, 1, 0); PG8_STAGE(PG8_SA(0, 1), a2 + hstepA, voffA);
            PG8_WAIT_L(8); PG8_BAR; PG8_WAIT_L(0); PG8_MMA(0, 0, At, B0); PG8_BAR; PG8_SCHED;
            PG8_LDB(B1, 1, 1); PG8_STAGE(PG8_SB(1, 0), b3, voffB);
            PG8_BAR; PG8_WAIT_L(0); PG8_MMA(0, 1, At, B1); PG8_BAR;
            PG8_LDA(At, 1, 1); PG8_STAGE(PG8_SA(1, 0), a3, voffA);
            PG8_BAR; PG8_WAIT_L(0); PG8_MMA(1, 0, At, B0); PG8_BAR; PG8_SCHED;
            PG8_STAGE(PG8_SB(1, 1), b3 + hstepB, voffB);
            PG8_WAIT_V(6); PG8_BAR; PG8_MMA(1, 1, At, B1); PG8_BAR;
        }
        E(acc, cur, wr, wc, fr, fq);
        if (!has_next) break;
#pragma unroll
        for (int a = 0; a < 2; ++a)
#pragma unroll
            for (int b = 0; b < 2; ++b)
#pragma unroll
                for (int m = 0; m < 4; ++m)
#pragma unroll
                    for (int n = 0; n < 2; ++n) acc[a][b][m][n] = (f32x4){0.f, 0.f, 0.f, 0.f};
        cur = nxt; cA = nA; cB = nB; ++ui;
    }
    PG8_WAIT_V(0);
    if (wr == 0) PG8_BAR;
    PG8_BAR;
#undef PG8_SA
#undef PG8_SB
#undef PG8_STAGE
#undef PG8_LDA
#undef PG8_LDB
#undef PG8_MMA
#undef PG8_WAIT_V
#undef PG8_WAIT_L
#undef PG8_BAR
#undef PG8_SCHED
#undef PG8_AOF
#undef PG8_BOF
}

__device__ __forceinline__ void tr_item(const float* W, int ldw, int k0, int n0, bf16_t* WT, int ldt, int drow0, int dk0, LAS float* scr, int lane) {
#pragma unroll 8
    for (int i = 0; i < 32; ++i) { const int kk = 2 * i + (lane >> 5); scr[kk * 33 + (lane & 31)] = W[(size_t)(k0 + kk) * ldw + n0 + (lane & 31)]; }
    LDS_WAIT(); asm volatile("" ::: "memory");
    const int c = lane & 7;
#pragma unroll
    for (int j = 0; j < 4; ++j) { const int n = (lane >> 3) + 8 * j; const LAS float* s = scr + (8 * c) * 33 + n;
        u32x4 o; o.x = cvt_pk_bf16(s[0 * 33], s[1 * 33]); o.y = cvt_pk_bf16(s[2 * 33], s[3 * 33]); o.z = cvt_pk_bf16(s[4 * 33], s[5 * 33]); o.w = cvt_pk_bf16(s[6 * 33], s[7 * 33]);
        *(u32x4*)(WT + (size_t)(drow0 + n) * ldt + dk0 + 8 * c) = o; }
    LDS_WAIT(); asm volatile("" ::: "memory");
}
#define TR_JOB(W, ldw, K, N, WT, ldt, DROW) do { const int nblk_ = (N) / 32, nit_ = ((K) / 64) * nblk_; \
    for (int it_ = gw; it_ < nit_; it_ += NGW) { const int kb_ = it_ / nblk_, nl = (it_ % nblk_) * 32; tr_item((W), (ldw), kb_ * 64, nl, (WT), (ldt), (DROW), kb_ * 64, scr, lane); } } while (0)

__device__ __forceinline__ void norm_rows(const float* Y, const float* Xin, float* Xout, const float* gpost, const float* gnext, bf16_t* H, int gw, int NGW, int lane) {
    for (int row = gw; row < MTOK; row += NGW) {
        const f32x4* xr = (const f32x4*)(Xin + (size_t)row * DM) + lane;
        f32x4 x[8];
#pragma unroll
        for (int j = 0; j < 8; ++j) x[j] = xr[64 * j];
        if (Y) {
            const f32x4* yr = (const f32x4*)(Y + (size_t)row * DM) + lane;
            f32x4 y[8]; float s = 0.f;
#pragma unroll
            for (int j = 0; j < 8; ++j) { y[j] = yr[64 * j]; s += (y[j][0] * y[j][0] + y[j][1] * y[j][1]) + (y[j][2] * y[j][2] + y[j][3] * y[j][3]); }
            const float rinv = rsqrtf(wave_sum(s) * (1.0f / DM) + 1e-6f);
#pragma unroll
            for (int j = 0; j < 8; ++j) { const f32x4 gp = *((const f32x4*)gpost + lane + 64 * j); x[j] = x[j] + y[j] * rinv * gp; }
        }
        if (Xout) { f32x4* xo = (f32x4*)(Xout + (size_t)row * DM) + lane;
#pragma unroll
            for (int j = 0; j < 8; ++j) xo[64 * j] = x[j]; }
        if (gnext) {
            float s = 0.f;
#pragma unroll
            for (int j = 0; j < 8; ++j) s += (x[j][0] * x[j][0] + x[j][1] * x[j][1]) + (x[j][2] * x[j][2] + x[j][3] * x[j][3]);
            const float rinv = rsqrtf(wave_sum(s) * (1.0f / DM) + 1e-6f);
            u32x2* ho = (u32x2*)(H + (size_t)row * DM) + lane;
#pragma unroll
            for (int j = 0; j < 8; ++j) { const f32x4 gn = *((const f32x4*)gnext + lane + 64 * j); const f32x4 v = x[j] * rinv * gn;
                u32x2 w; w.x = cvt_pk_bf16(v[0], v[1]); w.y = cvt_pk_bf16(v[2], v[3]); ho[64 * j] = w; }
        }
    }
}

__device__ __forceinline__ void rwkv_scan(LAS unsigned char* ldsb, int wi, const bf16_t* P, const float* DEC, const bf16_t* AB, float* YRAW,
                                          const float* mu, const float* k_k, const float* k_a, int tid) {
    const int lane = tid & 63, wid = tid >> 6;
    const int b = wi >> 5, h = (wi >> 1) & 15, half = wi & 1;
    LAS float* Rs = (LAS float*)ldsb; LAS float* Ws = Rs + 4096; LAS float* Ks = Ws + 4096; LAS float* As = Ks + 4096; LAS float* Bs = As + 4096;
    LAS float* Vs = Bs + 4096; LAS float* Ys = Vs + 2048;
    const int pt = tid >> 3, pc = (tid & 7) * 8;
    const int hc = h * 64 + pc;
    float mur[8], muk[8], muv[8], kkc[8], kac[8];
#pragma unroll
    for (int j = 0; j < 8; ++j) { mur[j] = mu[hc + j]; muk[j] = mu[1024 + hc + j]; muv[j] = mu[2048 + hc + j]; kkc[j] = k_k[hc + j]; kac[j] = k_a[hc + j]; }
    const int rowl = wid * 4 + (lane >> 4), kq = (lane & 15) * 4;
    float s0 = 0.f, s1 = 0.f, s2 = 0.f, s3 = 0.f;
    const size_t mbase = (size_t)b * TSEQ;
    u32x4 rc, rp, kc, kp, vc, vp, aw; f32x4 d0, d1;
    const u32x4 z4 = (u32x4){0u, 0u, 0u, 0u};
#define RW_LOAD(ch) do { const size_t m_ = mbase + (size_t)(ch) * 64 + pt; const bf16_t* pr_ = P + m_ * EVIN_NP + 1024 + hc; const bool hp_ = ((ch) * 64 + pt) > 0; \
        rc = *(const u32x4*)(pr_); kc = *(const u32x4*)(pr_ + 1024); vc = *(const u32x4*)(pr_ + 2048); \
        rp = hp_ ? *(const u32x4*)(pr_ - EVIN_NP) : z4; kp = hp_ ? *(const u32x4*)(pr_ - EVIN_NP + 1024) : z4; vp = hp_ ? *(const u32x4*)(pr_ - EVIN_NP + 2048) : z4; \
        aw = *(const u32x4*)(AB + m_ * 1024 + hc); d0 = *(const f32x4*)(DEC + m_ * 1024 + hc); d1 = *(const f32x4*)(DEC + m_ * 1024 + hc + 4); } while (0)
    RW_LOAD(0);
    for (int ch = 0; ch < TSEQ / 64; ++ch) {
        {
            float r[8], k[8], v[8], a[8], t8[8];
            unpack8(rc, r); unpack8(rp, t8);
#pragma unroll
            for (int j = 0; j < 8; ++j) r[j] = r[j] + (t8[j] - r[j]) * mur[j];
            unpack8(kc, k); unpack8(kp, t8);
#pragma unroll
            for (int j = 0; j < 8; ++j) k[j] = k[j] + (t8[j] - k[j]) * muk[j];
            unpack8(vc, v); unpack8(vp, t8);
#pragma unroll
            for (int j = 0; j < 8; ++j) v[j] = v[j] + (t8[j] - v[j]) * muv[j];
            unpack8(aw, a);
            float kk[8]; float ss = 0.f;
#pragma unroll
            for (int j = 0; j < 8; ++j) { kk[j] = k[j] * kkc[j]; ss += kk[j] * kk[j]; }
            ss += __shfl_xor(ss, 1); ss += __shfl_xor(ss, 2); ss += __shfl_xor(ss, 4);
            const float rn = rsqrtf(fmaxf(ss, 1e-24f));
            f32x4 o0, o1;
            LAS float* dst;
            dst = Rs + pt * 64 + pc; o0 = (f32x4){r[0], r[1], r[2], r[3]}; o1 = (f32x4){r[4], r[5], r[6], r[7]}; *(LAS f32x4*)dst = o0; *(LAS f32x4*)(dst + 4) = o1;
            dst = Ws + pt * 64 + pc; *(LAS f32x4*)dst = d0; *(LAS f32x4*)(dst + 4) = d1;
#pragma unroll
            for (int j = 0; j < 4; ++j) { o0[j] = k[j] * (1.0f + (a[j] - 1.0f) * kac[j]); o1[j] = k[4 + j] * (1.0f + (a[4 + j] - 1.0f) * kac[4 + j]); }
            dst = Ks + pt * 64 + pc; *(LAS f32x4*)dst = o0; *(LAS f32x4*)(dst + 4) = o1;
#pragma unroll
            for (int j = 0; j < 4; ++j) { o0[j] = -kk[j] * rn; o1[j] = -kk[4 + j] * rn; }
            dst = As + pt * 64 + pc; *(LAS f32x4*)dst = o0; *(LAS f32x4*)(dst + 4) = o1;
#pragma unroll
            for (int j = 0; j < 4; ++j) { o0[j] = kk[j] * rn * a[j]; o1[j] = kk[4 + j] * rn * a[4 + j]; }
            dst = Bs + pt * 64 + pc; *(LAS f32x4*)dst = o0; *(LAS f32x4*)(dst + 4) = o1;
            if ((pc >> 5) == half) { dst = Vs + pt * 32 + (pc & 31); o0 = (f32x4){v[0], v[1], v[2], v[3]}; o1 = (f32x4){v[4], v[5], v[6], v[7]}; *(LAS f32x4*)dst = o0; *(LAS f32x4*)(dst + 4) = o1; }
        }
        if (ch + 1 < TSEQ / 64) RW_LOAD(ch + 1);
        __syncthreads();
#pragma unroll 4
        for (int t = 0; t < 64; ++t) {
            const f32x4 a4 = *(const LAS f32x4*)(As + t * 64 + kq), w4 = *(const LAS f32x4*)(Ws + t * 64 + kq), b4 = *(const LAS f32x4*)(Bs + t * 64 + kq);
            const f32x4 k4 = *(const LAS f32x4*)(Ks + t * 64 + kq), r4 = *(const LAS f32x4*)(Rs + t * 64 + kq);
            const float vv = Vs[t * 32 + rowl];
            float sa = (s0 * a4[0] + s1 * a4[1]) + (s2 * a4[2] + s3 * a4[3]);
            sa = row16_sum(sa);
            s0 = s0 * w4[0] + (sa * b4[0] + vv * k4[0]);
            s1 = s1 * w4[1] + (sa * b4[1] + vv * k4[1]);
            s2 = s2 * w4[2] + (sa * b4[2] + vv * k4[2]);
            s3 = s3 * w4[3] + (sa * b4[3] + vv * k4[3]);
            float y = (s0 * r4[0] + s1 * r4[1]) + (s2 * r4[2] + s3 * r4[3]);
            y = row16_sum(y);
            if ((lane & 15) == 0) Ys[t * 32 + rowl] = y;
        }
        __syncthreads();
        {
            const int t = tid >> 3, j4 = (tid & 7) * 4;
            const f32x4 yv = *(const LAS f32x4*)(Ys + t * 32 + j4);
            *(f32x4*)(YRAW + (mbase + (size_t)ch * 64 + t) * 1024 + h * 64 + half * 32 + j4) = yv;
        }
    }
#undef RW_LOAD
}

__device__ __forceinline__ void rwkv_post(int gt, int NGT, const float* YRAW, const bf16_t* P, const bf16_t* AB, const bf16_t* GB, bf16_t* YCAT,
                                          const float* mu, const float* k_a, const float* r_k, const float* lnw, const float* lnb) {
    for (int it = gt; it < MTOK * 128; it += NGT) {
        const int m = it >> 7, hc = (it & 127) * 8;
        const bf16_t* pr = P + (size_t)m * EVIN_NP + 1024 + hc; const bool hp = (m & (TSEQ - 1)) != 0;
        const u32x4 z4 = (u32x4){0u, 0u, 0u, 0u};
        const u32x4 rc = *(const u32x4*)pr, kc = *(const u32x4*)(pr + 1024), vc = *(const u32x4*)(pr + 2048);
        const u32x4 rp = hp ? *(const u32x4*)(pr - EVIN_NP) : z4, kp = hp ? *(const u32x4*)(pr - EVIN_NP + 1024) : z4, vp = hp ? *(const u32x4*)(pr - EVIN_NP + 2048) : z4;
        const u32x4 aw = *(const u32x4*)(AB + (size_t)m * 1024 + hc), gw_ = *(const u32x4*)(GB + (size_t)m * 1024 + hc);
        const f32x4 y0 = *(const f32x4*)(YRAW + (size_t)m * 1024 + hc), y1 = *(const f32x4*)(YRAW + (size_t)m * 1024 + hc + 4);
        float r[8], k[8], v[8], a[8], gg[8], t8[8], y[8];
        unpack8(rc, r); unpack8(rp, t8);
#pragma unroll
        for (int j = 0; j < 8; ++j) r[j] = r[j] + (t8[j] - r[j]) * mu[hc + j];
        unpack8(kc, k); unpack8(kp, t8);
#pragma unroll
        for (int j = 0; j < 8; ++j) k[j] = k[j] + (t8[j] - k[j]) * mu[1024 + hc + j];
        unpack8(vc, v); unpack8(vp, t8);
#pragma unroll
        for (int j = 0; j < 8; ++j) v[j] = v[j] + (t8[j] - v[j]) * mu[2048 + hc + j];
        unpack8(aw, a); unpack8(gw_, gg);
#pragma unroll
        for (int j = 0; j < 4; ++j) { y[j] = y0[j]; y[4 + j] = y1[j]; }
        float s = 0.f, bo = 0.f;
#pragma unroll
        for (int j = 0; j < 8; ++j) { s += y[j]; const float kx = k[j] * (1.0f + (a[j] - 1.0f) * k_a[hc + j]); bo += r[j] * kx * r_k[hc + j]; }
        s += __shfl_xor(s, 1); s += __shfl_xor(s, 2); s += __shfl_xor(s, 4);
        bo += __shfl_xor(bo, 1); bo += __shfl_xor(bo, 2); bo += __shfl_xor(bo, 4);
        const float mean = s * (1.0f / 64.0f);
        float q = 0.f;
#pragma unroll
        for (int j = 0; j < 8; ++j) { y[j] -= mean; q += y[j] * y[j]; }
        q += __shfl_xor(q, 1); q += __shfl_xor(q, 2); q += __shfl_xor(q, 4);
        const float rstd = rsqrtf(q * (1.0f / 64.0f) + 64e-5f);
        float o[8];
#pragma unroll
        for (int j = 0; j < 8; ++j) o[j] = (y[j] * rstd * lnw[hc + j] + lnb[hc + j] + bo * v[j]) * gg[j];
        *(u32x4*)(YCAT + (size_t)m * DM + 1024 + hc) = pack8(o);
    }
}

__device__ __forceinline__ void s5_scan(LAS unsigned char* ldsb, int pair, const bf16_t* P, bf16_t* Y5, const float* lam_re, const float* lam_im, const float* log_dt,
                                        const float* b_re, const float* b_im, const float* c_re, const float* c_im, const float* dsk, int tid) {
    const int lane = tid & 63, wid = __builtin_amdgcn_readfirstlane(tid >> 6), fr = lane & 15, fq = lane >> 4;
    const int b = pair >> 6, g = pair & 63;
    LAS float* BR = (LAS float*)ldsb;
    LAS float* BI = BR + 64 * 68;
    LAS bf16_t* SR = (LAS bf16_t*)(BI + 64 * 68);
    LAS bf16_t* SI = SR + 64 * 72;
    const float dt = __expf(log_dt[g]);
    const int tt = wid & 3, ri = wid >> 2;
    bf16x8 bfrag[4];
#pragma unroll
    for (int pt = 0; pt < 4; ++pt) {
        const int p = pt * 16 + fr;
        const float lr = lam_re[g * 64 + p], li = lam_im[g * 64 + p];
        const float mag = __expf(lr * dt), ang = li * dt;
        const float are = mag * cosf(ang), aim = mag * sinf(ang);
        const float den = lr * lr + li * li, nr = are - 1.0f, ni = aim;
        const float gre = (nr * lr + ni * li) / den, gim = (ni * lr - nr * li) / den;
        float o[8];
#pragma unroll
        for (int e = 0; e < 8; ++e) {
            float val = 0.f;
            if (fq < 2) { const float br = b_re[(size_t)(g * 64 + p) * 16 + fq * 8 + e], bi = b_im[(size_t)(g * 64 + p) * 16 + fq * 8 + e];
                val = ri ? (gre * bi + gim * br) : (gre * br - gim * bi); }
            o[e] = val;
        }
        const u32x4 w = pack8(o); bfrag[pt] = __builtin_bit_cast(bf16x8, w);
    }
    float are_, aim_;
    { const float lr = lam_re[g * 64 + lane], li = lam_im[g * 64 + lane]; const float mag = __expf(lr * dt), ang = li * dt; are_ = mag * cosf(ang); aim_ = mag * sinf(ang); }
    bf16x8 cfrag[4];
#pragma unroll
    for (int kk = 0; kk < 4; ++kk) {
        float o[8];
#pragma unroll
        for (int e = 0; e < 8; ++e) { const int p = (kk & 1) * 32 + fq * 8 + e; o[e] = (kk < 2) ? c_re[(size_t)(g * 16 + fr) * 64 + p] : -c_im[(size_t)(g * 16 + fr) * 64 + p]; }
        const u32x4 w = pack8(o); cfrag[kk] = __builtin_bit_cast(bf16x8, w);
    }
    const f32x4 d4 = *(const f32x4*)(dsk + g * 16 + fq * 4);
    float sre = 0.f, sim = 0.f;
    const size_t m0 = (size_t)b * TSEQ;
    const u32x4 z4 = (u32x4){0u, 0u, 0u, 0u};
    u32x4 ucur = (fq < 2) ? *(const u32x4*)(P + (m0 + tt * 16 + fr) * EVIN_NP + g * 16 + fq * 8) : z4;
    for (int ch = 0; ch < TSEQ / 64; ++ch) {
        const size_t mc = m0 + (size_t)ch * 64;
        u32x4 unext = z4;
        if (ch + 1 < TSEQ / 64 && fq < 2) unext = *(const u32x4*)(P + (mc + 64 + tt * 16 + fr) * EVIN_NP + g * 16 + fq * 8);
        u32x2 usk = (u32x2){0u, 0u};
        if (wid < 4) usk = *(const u32x2*)(P + (mc + wid * 16 + fr) * EVIN_NP + g * 16 + fq * 4);
        {
            const bf16x8 ufrag = __builtin_bit_cast(bf16x8, ucur);
            LAS float* dst = (ri ? BI : BR) + (tt * 16 + fq * 4) * 68 + fr;
#pragma unroll
            for (int pt = 0; pt < 4; ++pt) {
                f32x4 d = (f32x4){0.f, 0.f, 0.f, 0.f};
                d = __builtin_amdgcn_mfma_f32_16x16x32_bf16(ufrag, bfrag[pt], d, 0, 0, 0);
#pragma unroll
                for (int jj = 0; jj < 4; ++jj) dst[jj * 68 + pt * 16] = d[jj];
            }
        }
        __syncthreads();
        if (wid == 0) {
#pragma unroll
            for (int t8 = 0; t8 < 8; ++t8) {
                float xr[8], xi[8];
#pragma unroll
                for (int i = 0; i < 8; ++i) { xr[i] = BR[(t8 * 8 + i) * 68 + lane]; xi[i] = BI[(t8 * 8 + i) * 68 + lane]; }
#pragma unroll
                for (int i = 0; i < 8; ++i) {
                    const float nre = are_ * sre - aim_ * sim + xr[i], nim = are_ * sim + aim_ * sre + xi[i];
                    sre = nre; sim = nim;
                    const unsigned w = cvt_pk_bf16(sre, sim);
                    SR[(t8 * 8 + i) * 72 + lane] = (bf16_t)(w & 0xffffu); SI[(t8 * 8 + i) * 72 + lane] = (bf16_t)(w >> 16);
                }
            }
        }
        __syncthreads();
        if (wid < 4) {
            f32x4 d = (f32x4){0.f, 0.f, 0.f, 0.f};
#pragma unroll
            for (int kk = 0; kk < 4; ++kk) {
                const LAS bf16_t* src = ((kk < 2) ? SR : SI) + (wid * 16 + fr) * 72 + (kk & 1) * 32 + fq * 8;
                const bf16x8 sfrag = *(const LAS bf16x8*)src;
                d = __builtin_amdgcn_mfma_f32_16x16x32_bf16(cfrag[kk], sfrag, d, 0, 0, 0);
            }
            const float u0 = bflo(usk.x), u1 = bfhi(usk.x), u2 = bflo(usk.y), u3 = bfhi(usk.y);
            const float y0 = gelu_t(d[0] + d4[0] * u0), y1 = gelu_t(d[1] + d4[1] * u1), y2 = gelu_t(d[2] + d4[2] * u2), y3 = gelu_t(d[3] + d4[3] * u3);
            u32x2 w; w.x = cvt_pk_bf16(y0, y1); w.y = cvt_pk_bf16(y2, y3);
            *(u32x2*)(Y5 + (mc + wid * 16 + fr) * 1024 + g * 16 + fq * 4) = w;
        }
        ucur = unext;
    }
}

__device__ __forceinline__ void lru_scan(LAS unsigned char* ldsb, int wi, const float* AA, const float* BX, const bf16_t* GATE, bf16_t* HG, int tid) {
    const int c = tid & 31, seg = tid >> 5;
    const int b = wi >> 6, ch = (wi & 63) * 32 + c;
    LAS float* SA = (LAS float*)ldsb; LAS float* SH = SA + 512;
    const size_t base = ((size_t)b * TSEQ + (size_t)seg * 256) * DM + ch;
    float Ap = 1.f, h = 0.f;
#pragma unroll 8
    for (int t = 0; t < 256; ++t) { const float a = AA[base + (size_t)t * DM], x = BX[base + (size_t)t * DM]; h = a * h + x; Ap *= a; }
    SA[seg * 32 + c] = Ap; SH[seg * 32 + c] = h;
    __syncthreads();
    float hin = 0.f;
    for (int s = 0; s < seg; ++s) hin = SA[s * 32 + c] * hin + SH[s * 32 + c];
    h = hin;
#pragma unroll 8
    for (int t = 0; t < 256; ++t) { const float a = AA[base + (size_t)t * DM], x = BX[base + (size_t)t * DM]; h = a * h + x;
        const float gt = __uint_as_float((unsigned)GATE[base + (size_t)t * DM] << 16);
        HG[base + (size_t)t * DM] = (bf16_t)(cvt_pk_bf16(h * gt, 0.f) & 0xffffu); }
    __syncthreads();
}

typedef __attribute__((address_space(4))) const Params CParams;
#define KP() ({ CParams* q_ = pp; asm volatile("" : "+s"(q_)); q_; })
#define PIN(i) (KP()->in[i])
#define ws (KP()->ws)
#define XRES (KP()->out)
#define H ((bf16_t*)(ws + WS_H))
#define P ((bf16_t*)(ws + WS_P))
#define YMIX ((float*)(ws + WS_YMIX))
#define ACT ((bf16_t*)(ws + WS_ACT))
#define tid ({ int t_ = wave_s * 64 + (int)__builtin_amdgcn_mbcnt_hi(~0u, __builtin_amdgcn_mbcnt_lo(~0u, 0u)); asm volatile("" : "+v"(t_)); t_; })
#define lane (tid & 63)
#define wid (__builtin_amdgcn_readfirstlane(tid >> 6))
#define gw (bid * NWAVES + wid)
#define gt (bid * NTHREADS + tid)

template <int layer>
__device__ __forceinline__ void layer_body(CParams* pp, const int wave_s, LAS unsigned char* lds, cg::grid_group& grid) {
    const int G = gridDim.x, bid = blockIdx.x;
    const int NGW = G * NWAVES, NGT = G * NTHREADS;
        const int li = layer >> 1;
        if ((layer & 1) == 0) {
            const float* mu = PIN(2) + (size_t)li * 3360;
            { Gemm g{H, (const bf16_t*)(ws + WS_EVIN + li * SZ_EVIN), DM, DM, 0, 0}; StaticOrder S; S.init(MTOK, EVIN_NP, G, bid);
              EpiBf16 E{P, EVIN_NP}; gemm_phase<EpiBf16>(lds, g, S, E, tid); }
            grid.sync();
            {
                bf16_t* LRA = (bf16_t*)(ws + WS_LRACT);
                for (int i = gt; i < MTOK * LRK; i += NGT) {
                    const int m = i / LRK, j = i % LRK; float v = 0.f;
                    if (j < 288) { const int col = 4096 + j; const float z = __uint_as_float((unsigned)P[(size_t)m * EVIN_NP + col] << 16);
                        const float zp = (m & (TSEQ - 1)) ? __uint_as_float((unsigned)P[(size_t)(m - 1) * EVIN_NP + col] << 16) : 0.f;
                        const float zz = z + (zp - z) * mu[col - 1024];
                        v = (j < 64) ? (2.0f * sigm(2.0f * zz) - 1.0f) : ((j < 128) ? zz : sigm(zz)); }
                    LRA[i] = (bf16_t)(cvt_pk_bf16(v, 0.f) & 0xffffu);
                }
            }
            grid.sync();
            { Gemm g{(const bf16_t*)(ws + WS_LRACT), (const bf16_t*)(ws + WS_LR + li * SZ_LR), LRK, LRK, 0, 0}; StaticOrder S; S.init(MTOK, 3072, G, bid);
              EpiLR E{(float*)(ws + WS_DEC), (bf16_t*)(ws + WS_AB), (bf16_t*)(ws + WS_GB), PIN(12) + li * 1024, PIN(14) + li * 1024}; gemm_phase<EpiLR>(lds, g, S, E, tid); }
            grid.sync();
            for (int wi = bid; wi < 192; wi += G) {
                if (wi < 64) rwkv_scan(lds, wi, P, (const float*)(ws + WS_DEC), (const bf16_t*)(ws + WS_AB), (float*)(ws + WS_YRAW), mu, PIN(17) + li * 1024, PIN(18) + li * 1024, tid);
                else s5_scan(lds, wi - 64, P, (bf16_t*)(ws + WS_Y5), PIN(3) + li * 4096, PIN(4) + li * 4096, PIN(5) + li * 64,
                             PIN(6) + (size_t)li * 65536, PIN(7) + (size_t)li * 65536, PIN(8) + (size_t)li * 65536, PIN(9) + (size_t)li * 65536, PIN(10) + li * 1024, tid);
                __syncthreads();
            }
            grid.sync();
            {
                Gemm g{(const bf16_t*)(ws + WS_Y5), (const bf16_t*)(ws + WS_GLU + li * SZ_GLU), 1024, 1024, 0, 0}; StaticOrder S; S.init(MTOK, 1024, G, bid);
                EpiGLU E{(const bf16_t*)(ws + WS_Y5), (bf16_t*)(ws + WS_YCAT)}; gemm_phase<EpiGLU>(lds, g, S, E, tid);
                if (bid >= 128 || G < 256) {
                    const int nb = (G < 256) ? G : (G - 128), b0 = (G < 256) ? bid : (bid - 128);
                    rwkv_post(b0 * NTHREADS + tid, nb * NTHREADS, (const float*)(ws + WS_YRAW), P, (const bf16_t*)(ws + WS_AB), (const bf16_t*)(ws + WS_GB), (bf16_t*)(ws + WS_YCAT),
                              mu, PIN(18) + li * 1024, PIN(19) + li * 1024, PIN(20) + li * 1024, PIN(21) + li * 1024);
                }
            }
            grid.sync();
            { Gemm g{(const bf16_t*)(ws + WS_YCAT), (const bf16_t*)(ws + WS_EVOUT + li * SZ_SQ), DM, DM, 0, 0}; StaticOrder S; S.init(MTOK, DM, G, bid);
              EpiF32 E{YMIX, DM}; gemm_phase<EpiF32>(lds, g, S, E, tid); }
            grid.sync();
        } else {
            bf16_t* GATE = (bf16_t*)(ws + WS_GATE); bf16_t* XB = (bf16_t*)(ws + WS_XB); bf16_t* XC = (bf16_t*)(ws + WS_XC);
            { Gemm g{H, (const bf16_t*)(ws + WS_ODIN + li * SZ_ODIN), DM, DM, 0, 0}; StaticOrder S; S.init(MTOK, 4096, G, bid);
              EpiOddIn E{GATE, XB}; gemm_phase<EpiOddIn>(lds, g, S, E, tid); }
            grid.sync();
            {
                const float* cw = PIN(24) + (size_t)li * 4 * DM; const float* cb = PIN(25) + (size_t)li * DM;
                for (int i = gt; i < MTOK * (DM / 8); i += NGT) {
                    const int m = i >> 8, c8 = (i & 255) * 8, t = m & (TSEQ - 1);
                    float acc[8];
#pragma unroll
                    for (int j = 0; j < 8; ++j) acc[j] = cb[c8 + j];
#pragma unroll
                    for (int q = 0; q < 4; ++q) {
                        if (t - 3 + q >= 0) { const u32x4 xw = *(const u32x4*)(XB + (size_t)(m - 3 + q) * DM + c8); float xv[8]; unpack8(xw, xv);
#pragma unroll
                            for (int j = 0; j < 8; ++j) acc[j] += cw[q * DM + c8 + j] * xv[j]; }
                    }
                    *(u32x4*)(XC + (size_t)m * DM + c8) = pack8(acc);
                }
            }
            grid.sync();
            { Gemm g{XC, (const bf16_t*)(ws + WS_GATES + li * SZ_GATES), DM, 256, 1, 256}; StaticOrder S; S.init(MTOK, 4096, G, bid);
              EpiGates E{XC, (float*)(ws + WS_AA), (float*)(ws + WS_BX), PIN(27) + li * DM, PIN(29) + li * DM, PIN(30) + li * DM}; gemm_phase<EpiGates>(lds, g, S, E, tid); }
            grid.sync();
            for (int wi = bid; wi < 128; wi += G) lru_scan(lds, wi, (const float*)(ws + WS_AA), (const float*)(ws + WS_BX), GATE, XB  , tid);
            grid.sync();
            { Gemm g{XB  , (const bf16_t*)(ws + WS_ODOUT + li * SZ_SQ), DM, DM, 0, 0}; StaticOrder S; S.init(MTOK, DM, G, bid);
              EpiF32 E{YMIX, DM}; gemm_phase<EpiF32>(lds, g, S, E, tid); }
            grid.sync();
        }
        norm_rows(YMIX, XRES, XRES, PIN(36) + layer * DM, PIN(37) + layer * DM, H, gw, NGW, lane);
        grid.sync();
        { Gemm g{H, (const bf16_t*)(ws + WS_GU + layer * SZ_GU), DM, DM, 0, 0}; StaticOrder S; S.init(MTOK, 2 * DFF, G, bid);
          EpiGU E{ACT}; gemm_phase<EpiGU>(lds, g, S, E, tid); }
        grid.sync();
        { Gemm g{ACT, (const bf16_t*)(ws + WS_DN + layer * SZ_DN), DFF, DFF, 0, 0}; StaticOrder S; S.init(MTOK, DM, G, bid);
          EpiF32 E{YMIX, DM}; gemm_phase<EpiF32>(lds, g, S, E, tid); }
        grid.sync();
        norm_rows(YMIX, XRES, XRES, PIN(38) + layer * DM, (layer < 3) ? (PIN(35) + (layer + 1) * DM) : nullptr, H, gw, NGW, lane);
        if (layer < 3) grid.sync();
}

__global__ void __launch_bounds__(NTHREADS) mega_fwd(Params p) {
    extern __shared__ __attribute__((aligned(16))) unsigned char lds_raw[];
    LAS unsigned char* lds = (LAS unsigned char*)lds_raw;
    cg::grid_group grid = cg::this_grid();
    CParams* pp = (CParams*)__builtin_amdgcn_kernarg_segment_ptr();
    const int wave_s = __builtin_amdgcn_readfirstlane(threadIdx.x >> 6);
    const int G = gridDim.x, bid = blockIdx.x;
    const int NGW = G * NWAVES, NGT = G * NTHREADS;

    {
        LAS float* scr = (LAS float*)(lds + wid * 8448);
        for (int e = 0; e < 2; ++e) {
            bf16_t* wevin = (bf16_t*)(ws + WS_EVIN + e * SZ_EVIN);
            TR_JOB(PIN(1) + (size_t)e * DM * EVIN_N, EVIN_N, DM, EVIN_N, wevin, DM, nl);
            for (int i = gt; i < (EVIN_NP - EVIN_N) * DM / 8; i += NGT) *(u32x4*)(wevin + (size_t)EVIN_N * DM + (size_t)i * 8) = (u32x4){0u, 0u, 0u, 0u};
            TR_JOB(PIN(11) + (size_t)e * 1024 * 1024, 1024, 1024, 1024, (bf16_t*)(ws + WS_GLU + e * SZ_GLU), 1024, nl);
            TR_JOB(PIN(22) + (size_t)e * DM * DM, DM, DM, DM, (bf16_t*)(ws + WS_EVOUT + e * SZ_SQ), DM, nl);
            {
                bf16_t* wlr = (bf16_t*)(ws + WS_LR + e * SZ_LR);
                const float* w2 = PIN(13) + (size_t)e * 64 * 1024; const float* a2 = PIN(15) + (size_t)e * 64 * 1024; const float* g2 = PIN(16) + (size_t)e * 160 * 1024;
                for (int i = gt; i < 3072 * (LRK / 8); i += NGT) {
                    const int n = i / (LRK / 8), k8 = (i % (LRK / 8)) * 8, type = n >> 10, nn = n & 1023;
                    float o[8];
#pragma unroll
                    for (int j = 0; j < 8; ++j) { const int k = k8 + j; float v = 0.f;
                        if (type == 0) { if (k < 64) v = w2[(size_t)k * 1024 + nn]; }
                        else if (type == 1) { if (k >= 64 && k < 128) v = a2[(size_t)(k - 64) * 1024 + nn]; }
                        else { if (k >= 128 && k < 288) v = g2[(size_t)(k - 128) * 1024 + nn]; }
                        o[j] = v; }
                    *(u32x4*)(wlr + (size_t)n * LRK + k8) = pack8(o);
                }
            }
        }
        for (int o = 0; o < 2; ++o) {
            TR_JOB(PIN(23) + (size_t)o * DM * 4096, 4096, DM, 4096, (bf16_t*)(ws + WS_ODIN + o * SZ_ODIN), DM, nl);
            TR_JOB(PIN(31) + (size_t)o * DM * DM, DM, DM, DM, (bf16_t*)(ws + WS_ODOUT + o * SZ_SQ), DM, nl);
            bf16_t* wg = (bf16_t*)(ws + WS_GATES + o * SZ_GATES);
            for (int it = gw; it < 16 * 32; it += NGW) {
                const int job = it >> 5, sub = it & 31, blk = job >> 1, ri = job & 1, kb = sub >> 3, nl = (sub & 7) * 32;
                const float* W = (ri ? PIN(28) : PIN(26)) + (size_t)(o * 8 + blk) * 65536;
                tr_item(W, 256, kb * 64, nl, wg, 256, (2 * blk + (nl >> 7)) * 256 + ri * 128 + (nl & 127), kb * 64, scr, lane);
            }
        }
        for (int l = 0; l < 4; ++l) {
            bf16_t* wgu = (bf16_t*)(ws + WS_GU + l * SZ_GU);
            TR_JOB(PIN(32) + (size_t)l * DM * DFF, DFF, DM, DFF, wgu, DM, (nl >> 7) * 256 + (nl & 127));
            TR_JOB(PIN(33) + (size_t)l * DM * DFF, DFF, DM, DFF, wgu, DM, (nl >> 7) * 256 + 128 + (nl & 127));
            TR_JOB(PIN(34) + (size_t)l * DFF * DM, DM, DFF, DM, (bf16_t*)(ws + WS_DN + l * SZ_DN), DFF, nl);
        }
        norm_rows(nullptr, PIN(0), XRES, nullptr, PIN(35), H, gw, NGW, lane);
    }
    grid.sync();

    layer_body<0>(pp, wave_s, lds, grid);
    layer_body<1>(pp, wave_s, lds, grid);
    layer_body<2>(pp, wave_s, lds, grid);
    layer_body<3>(pp, wave_s, lds, grid);
}

#undef KP
#undef PIN
#undef ws
#undef XRES
#undef H
#undef P
#undef YMIX
#undef ACT
#undef tid
#undef lane
#undef wid
#undef gw
#undef gt

extern "C" void kernel_launch(void* const* d_in, const int* in_sizes, int n_in, void* d_out, int out_size, void* d_ws, size_t ws_size, hipStream_t stream) {
    static int grid = 0;
    if (grid == 0) {
        if (n_in != 39 || out_size != MTOK * DM || ws_size < WS_END) { fprintf(stderr, "kernel_launch: unexpected shapes (n_in %d out %d ws %zu need %zu)\n", n_in, out_size, ws_size, (size_t)WS_END); grid = -1; return; }
        int dev = 0, cus = 0, per_cu = 0;
        (void)hipGetDevice(&dev);
        (void)hipDeviceGetAttribute(&cus, hipDeviceAttributeMultiprocessorCount, dev);
        if (hipFuncSetAttribute((const void*)mega_fwd, hipFuncAttributeMaxDynamicSharedMemorySize, LDS_BYTES) != hipSuccess) { fprintf(stderr, "kernel_launch: hipFuncSetAttribute failed\n"); grid = -1; return; }
        if (hipOccupancyMaxActiveBlocksPerMultiprocessor(&per_cu, (const void*)mega_fwd, NTHREADS, LDS_BYTES) != hipSuccess || per_cu < 1) { fprintf(stderr, "kernel_launch: occupancy query gave %d\n", per_cu); per_cu = 1; }
        (void)hipGetLastError();
        grid = cus * 1;
    }
    if (grid < 0) return;
    Params p{};
    for (int i = 0; i < 39; ++i) p.in[i] = (const float*)d_in[i];
    p.out = (float*)d_out; p.ws = (unsigned char*)d_ws;
    void* args[] = {&p};
    hipError_t e = hipLaunchCooperativeKernel((const void*)mega_fwd, dim3(grid), dim3(NTHREADS), args, LDS_BYTES, stream);
    if (e != hipSuccess) fprintf(stderr, "cooperative launch failed: %s (grid %d)\n", hipGetErrorString(e), grid);
}
```

```cpp
#include <hip/hip_runtime.h>
#include <hip/hip_cooperative_groups.h>
#include <cstdio>
namespace cg = cooperative_groups;

#define LAS __attribute__((address_space(3)))
typedef unsigned short bf16_t;
typedef short bf16x8 __attribute__((ext_vector_type(8)));
typedef float f32x4 __attribute__((ext_vector_type(4)));
typedef unsigned u32x4 __attribute__((ext_vector_type(4)));
typedef unsigned u32x2 __attribute__((ext_vector_type(2)));

constexpr int MTOK = 8192, TSEQ = 4096, DM = 2048, DFF = 5632;
constexpr int EVIN_N = 4384, EVIN_NP = 4608, LRK = 384;
constexpr int NTHREADS = 512, NWAVES = 8;
constexpr int BM = 256, BK = 64, HALF = 128, HTB = HALF * BK * 2, STAGE_BYTES = 8 * HTB, NXCD = 8, WGM = 8;
constexpr int LDS_BYTES = STAGE_BYTES;

constexpr size_t al256(size_t x) { return (x + 255) & ~(size_t)255; }
constexpr size_t SZ_EVIN = (size_t)EVIN_NP * DM * 2, SZ_GLU = (size_t)1024 * 1024 * 2, SZ_LR = (size_t)3072 * LRK * 2, SZ_SQ = (size_t)DM * DM * 2;
constexpr size_t SZ_ODIN = (size_t)4096 * DM * 2, SZ_GATES = (size_t)4096 * 256 * 2, SZ_GU = (size_t)2 * DFF * DM * 2, SZ_DN = (size_t)DM * DFF * 2;
constexpr size_t WS_EVIN = 0;
constexpr size_t WS_GLU = WS_EVIN + 2 * SZ_EVIN;
constexpr size_t WS_LR = WS_GLU + 2 * SZ_GLU;
constexpr size_t WS_EVOUT = WS_LR + 2 * SZ_LR;
constexpr size_t WS_ODIN = WS_EVOUT + 2 * SZ_SQ;
constexpr size_t WS_GATES = WS_ODIN + 2 * SZ_ODIN;
constexpr size_t WS_ODOUT = WS_GATES + 2 * SZ_GATES;
constexpr size_t WS_GU = WS_ODOUT + 2 * SZ_SQ;
constexpr size_t WS_DN = WS_GU + 4 * SZ_GU;
constexpr size_t WS_H = WS_DN + 4 * SZ_DN;
constexpr size_t WS_P = WS_H + (size_t)MTOK * DM * 2;
constexpr size_t WS_YMIX = WS_P + (size_t)MTOK * EVIN_NP * 2;
constexpr size_t WS_ACT = WS_YMIX + (size_t)MTOK * DM * 4;
constexpr size_t WS_MIX2 = WS_ACT + (size_t)MTOK * DFF * 2;
constexpr size_t WS_END = WS_MIX2 + (size_t)MTOK * DM * 4;
constexpr size_t WS_LRACT = WS_ACT;
constexpr size_t WS_DEC = WS_LRACT + (size_t)MTOK * LRK * 2;
constexpr size_t WS_AB = WS_DEC + (size_t)MTOK * 1024 * 4;
constexpr size_t WS_GB = WS_AB + (size_t)MTOK * 1024 * 2;
constexpr size_t WS_Y5 = WS_GB + (size_t)MTOK * 1024 * 2;
static_assert(WS_Y5 + (size_t)MTOK * 1024 * 2 <= WS_MIX2, "even temporaries overflow ACT");
constexpr size_t WS_YRAW = WS_MIX2;
constexpr size_t WS_YCAT = WS_MIX2 + (size_t)MTOK * 1024 * 4;
constexpr size_t WS_GATE = WS_P;
constexpr size_t WS_XB = WS_P + (size_t)MTOK * DM * 2;
constexpr size_t WS_XC = WS_YMIX;
constexpr size_t WS_AA = WS_ACT;
constexpr size_t WS_BX = WS_MIX2;

struct Params { const float* in[39]; float* out; unsigned char* ws; };

__device__ __forceinline__ unsigned cvt_pk_bf16(float lo, float hi) { unsigned r; asm volatile("v_cvt_pk_bf16_f32 %0, %1, %2" : "=v"(r) : "v"(lo), "v"(hi)); return r; }
__device__ __forceinline__ float bflo(unsigned w) { return __uint_as_float(w << 16); }
__device__ __forceinline__ float bfhi(unsigned w) { return __uint_as_float(w & 0xffff0000u); }
__device__ __forceinline__ float sigm(float x) { return __builtin_amdgcn_rcpf(1.0f + __expf(-x)); }
__device__ __forceinline__ float gelu_t(float x) { return x * sigm(1.5957691216057308f * (x + 0.044715f * x * x * x)); }
__device__ __forceinline__ float softplus_f(float z) { return fmaxf(z, 0.f) + __logf(1.0f + __expf(-fabsf(z))); }
__device__ __forceinline__ void unpack8(const u32x4 w, float (&f)[8]) {
    f[0] = bflo(w.x); f[1] = bfhi(w.x); f[2] = bflo(w.y); f[3] = bfhi(w.y); f[4] = bflo(w.z); f[5] = bfhi(w.z); f[6] = bflo(w.w); f[7] = bfhi(w.w);
}
__device__ __forceinline__ u32x4 pack8(const float (&f)[8]) { u32x4 w; w.x = cvt_pk_bf16(f[0], f[1]); w.y = cvt_pk_bf16(f[2], f[3]); w.z = cvt_pk_bf16(f[4], f[5]); w.w = cvt_pk_bf16(f[6], f[7]); return w; }
__device__ __forceinline__ float wave_sum(float v) {
#pragma unroll
    for (int o = 1; o < 64; o <<= 1) v += __shfl_xor(v, o);
    return v;
}
template <int CTRL> __device__ __forceinline__ float dpp_f(float x) { return __int_as_float(__builtin_amdgcn_update_dpp(0, __float_as_int(x), CTRL, 0xf, 0xf, true)); }
__device__ __forceinline__ float row16_sum(float x) {
    x += dpp_f<0xB1>(x);
    x += dpp_f<0x4E>(x);
    x += dpp_f<0x141>(x);
    x += dpp_f<0x140>(x);
    return x;
}
#define LDS_WAIT() asm volatile("s_waitcnt lgkmcnt(0)" ::: "memory")

__device__ __forceinline__ int lds_byte(int r, int c) { const int st = (r >> 4) * 2 + (c >> 5), rr = r & 15, cc = c & 31, ob = rr * 64 + cc * 2; return st * 1024 + (ob ^ (((ob >> 9) & 1) << 5)); }
__device__ __forceinline__ void stage_rc(int b, int& R, int& C) { const int st = b / 1024, sb = b % 1024, swz = sb ^ (((sb >> 9) & 1) << 5); R = (st >> 1) * 16 + swz / 64; C = (st & 1) * 32 + (swz % 64) / 2; }
__device__ __forceinline__ int perm32(int rho) { const int n = rho >> 4, i = rho & 15; return 8 * (i >> 2) + 4 * n + (i & 3); }

struct Unit { int pm, pn; };
struct Gemm { const bf16_t* A; const bf16_t* Bt; int lda, K, apn_shift, apn_mul; };
struct StaticOrder {
    int nM, nN, nwg, G, c;
    __device__ void init(int M, int N, int G_, int c_) { nM = M / BM; nN = N / BM; nwg = nM * nN; G = G_; c = c_; }
    __device__ bool next(int i, Unit& u) const {
        const long L = (long)i * G + c; if (L >= nwg) return false;
        int wgid = (int)L; { const int q = nwg / NXCD, r = nwg % NXCD, xcd = wgid % NXCD, off = wgid / NXCD; wgid = (xcd < r ? xcd * (q + 1) : r * (q + 1) + (xcd - r) * q) + off; }
        const int nig = WGM * nN, gid = wgid / nig, fm = gid * WGM, gsz = (nM - fm) < WGM ? (nM - fm) : WGM;
        u.pm = fm + ((wgid % nig) % gsz); u.pn = (wgid % nig) / gsz; return true;
    }
};

struct EpiF32 {
    static constexpr bool PERM = false;
    float* C; int ldc;
    __device__ __forceinline__ void operator()(const f32x4 (&acc)[2][2][4][2], const Unit& u, int wr, int wc, int fr, int fq) const {
        const int row0 = u.pm * BM + wr * 64 + fr, col0 = u.pn * BM + wc * 32 + 4 * fq;
#pragma unroll
        for (int ai = 0; ai < 2; ++ai)
#pragma unroll
            for (int m = 0; m < 4; ++m) { float* rowp = C + (size_t)(row0 + ai * HALF + m * 16) * ldc + col0;
#pragma unroll
                for (int bj = 0; bj < 2; ++bj)
#pragma unroll
                    for (int n = 0; n < 2; ++n) *(f32x4*)(rowp + bj * HALF + n * 16) = acc[ai][bj][m][n]; }
    }
};
struct EpiBf16 {
    static constexpr bool PERM = true;
    bf16_t* O; int ldc;
    __device__ __forceinline__ void operator()(const f32x4 (&acc)[2][2][4][2], const Unit& u, int wr, int wc, int fr, int fq) const {
        const int row0 = u.pm * BM + wr * 64 + fr, col0 = u.pn * BM + wc * 32 + 8 * fq;
#pragma unroll
        for (int ai = 0; ai < 2; ++ai)
#pragma unroll
            for (int m = 0; m < 4; ++m) { bf16_t* rowp = O + (size_t)(row0 + ai * HALF + m * 16) * ldc + col0;
#pragma unroll
                for (int bj = 0; bj < 2; ++bj) { const f32x4 v0 = acc[ai][bj][m][0], v1 = acc[ai][bj][m][1];
                    u32x4 w; w.x = cvt_pk_bf16(v0[0], v0[1]); w.y = cvt_pk_bf16(v0[2], v0[3]); w.z = cvt_pk_bf16(v1[0], v1[1]); w.w = cvt_pk_bf16(v1[2], v1[3]);
                    *(u32x4*)(rowp + bj * HALF) = w; } }
    }
};
struct EpiOddIn {
    static constexpr bool PERM = true;
    bf16_t* GATE; bf16_t* XB;
    __device__ __forceinline__ void operator()(const f32x4 (&acc)[2][2][4][2], const Unit& u, int wr, int wc, int fr, int fq) const {
        const bool isg = u.pn < 8; bf16_t* base = isg ? GATE : XB;
        const int row0 = u.pm * BM + wr * 64 + fr, col0 = (u.pn & 7) * BM + wc * 32 + 8 * fq;
#pragma unroll
        for (int ai = 0; ai < 2; ++ai)
#pragma unroll
            for (int m = 0; m < 4; ++m) { bf16_t* rowp = base + (size_t)(row0 + ai * HALF + m * 16) * DM + col0;
#pragma unroll
                for (int bj = 0; bj < 2; ++bj) { f32x4 v0 = acc[ai][bj][m][0], v1 = acc[ai][bj][m][1];
                    if (isg) {
#pragma unroll
                        for (int j = 0; j < 4; ++j) { v0[j] = gelu_t(v0[j]); v1[j] = gelu_t(v1[j]); } }
                    u32x4 w; w.x = cvt_pk_bf16(v0[0], v0[1]); w.y = cvt_pk_bf16(v0[2], v0[3]); w.z = cvt_pk_bf16(v1[0], v1[1]); w.w = cvt_pk_bf16(v1[2], v1[3]);
                    *(u32x4*)(rowp + bj * HALF) = w; } }
    }
};
struct EpiLR {
    static constexpr bool PERM = true;
    float* DEC; bf16_t* AB; bf16_t* GB; const float* w0; const float* a0;
    __device__ __forceinline__ void operator()(const f32x4 (&acc)[2][2][4][2], const Unit& u, int wr, int wc, int fr, int fq) const {
        const int type = u.pn >> 2;
        bf16_t* obase = AB; if (type == 2) obase = GB;
        const int row0 = u.pm * BM + wr * 64 + fr, col0 = (u.pn & 3) * BM + wc * 32 + 8 * fq;
#pragma unroll
        for (int bj = 0; bj < 2; ++bj) {
            const int col = col0 + bj * HALF;
            f32x4 c0 = (f32x4){0.f, 0.f, 0.f, 0.f}, c1 = c0;
            if (type == 0) { c0 = *(const f32x4*)(w0 + col); c1 = *(const f32x4*)(w0 + col + 4); }
            else if (type == 1) { c0 = *(const f32x4*)(a0 + col); c1 = *(const f32x4*)(a0 + col + 4); }
#pragma unroll
            for (int ai = 0; ai < 2; ++ai)
#pragma unroll
                for (int m = 0; m < 4; ++m) {
                    const size_t off = (size_t)(row0 + ai * HALF + m * 16) * 1024 + col;
                    f32x4 v0 = acc[ai][bj][m][0] + c0, v1 = acc[ai][bj][m][1] + c1;
                    if (type == 0) {
#pragma unroll
                        for (int j = 0; j < 4; ++j) { v0[j] = __expf(-__expf(-softplus_f(-v0[j]) - 0.5f)); v1[j] = __expf(-__expf(-softplus_f(-v1[j]) - 0.5f)); }
                        *(f32x4*)(DEC + off) = v0; *(f32x4*)(DEC + off + 4) = v1;
                    } else {
                        if (type == 1) {
#pragma unroll
                            for (int j = 0; j < 4; ++j) { v0[j] = sigm(v0[j]); v1[j] = sigm(v1[j]); } }
                        u32x4 w; w.x = cvt_pk_bf16(v0[0], v0[1]); w.y = cvt_pk_bf16(v0[2], v0[3]); w.z = cvt_pk_bf16(v1[0], v1[1]); w.w = cvt_pk_bf16(v1[2], v1[3]);
                        *(u32x4*)(obase + off) = w;
                    }
                }
        }
    }
};
struct EpiGLU {
    static constexpr bool PERM = true;
    const bf16_t* Y5; bf16_t* YCAT;
    __device__ __forceinline__ void operator()(const f32x4 (&acc)[2][2][4][2], const Unit& u, int wr, int wc, int fr, int fq) const {
        const int row0 = u.pm * BM + wr * 64 + fr, col0 = u.pn * BM + wc * 32 + 8 * fq;
#pragma unroll
        for (int ai = 0; ai < 2; ++ai)
#pragma unroll
            for (int m = 0; m < 4; ++m) { const int row = row0 + ai * HALF + m * 16;
#pragma unroll
                for (int bj = 0; bj < 2; ++bj) { const f32x4 v0 = acc[ai][bj][m][0], v1 = acc[ai][bj][m][1];
                    const u32x4 yw = *(const u32x4*)(Y5 + (size_t)row * 1024 + col0 + bj * HALF);
                    float y[8]; unpack8(yw, y);
                    float o[8];
#pragma unroll
                    for (int j = 0; j < 4; ++j) { o[j] = y[j] * sigm(v0[j]); o[4 + j] = y[4 + j] * sigm(v1[j]); }
                    *(u32x4*)(YCAT + (size_t)row * DM + col0 + bj * HALF) = pack8(o); } }
    }
};
struct EpiGates {
    static constexpr bool PERM = true;
    const bf16_t* XC; float* AA; float* BX; const float* b_r; const float* b_i; const float* lam;
    __device__ __forceinline__ void operator()(const f32x4 (&acc)[2][2][4][2], const Unit& u, int wr, int wc, int fr, int fq) const {
        const int row0 = u.pm * BM + wr * 64 + fr, ch0 = (u.pn >> 1) * 256 + (u.pn & 1) * 128 + wc * 32 + 8 * fq;
#pragma unroll
        for (int ai = 0; ai < 2; ++ai)
#pragma unroll
            for (int m = 0; m < 4; ++m) { const int row = row0 + ai * HALF + m * 16; const size_t off = (size_t)row * DM + ch0;
                const u32x4 xw = *(const u32x4*)(XC + off); float xc[8]; unpack8(xw, xc);
#pragma unroll
                for (int n = 0; n < 2; ++n) {
                    const f32x4 br = *(const f32x4*)(b_r + ch0 + 4 * n), bi = *(const f32x4*)(b_i + ch0 + 4 * n), lm = *(const f32x4*)(lam + ch0 + 4 * n);
                    f32x4 av, bv;
#pragma unroll
                    for (int j = 0; j < 4; ++j) {
                        const float gr = acc[ai][0][m][n][j] + br[j], gi = acc[ai][1][m][n][j] + bi[j];
                        const float la = -8.0f * sigm(gr) * softplus_f(-lm[j]);
                        const float a = __expf(la);
                        const float mult = sqrtf(fmaxf(1.0f - __expf(2.0f * la), 0.f));
                        av[j] = a; bv[j] = mult * sigm(gi) * xc[4 * n + j];
                    }
                    *(f32x4*)(AA + off + 4 * n) = av; *(f32x4*)(BX + off + 4 * n) = bv;
                } }
    }
};
struct EpiGU {
    static constexpr bool PERM = true;
    bf16_t* ACT;
    __device__ __forceinline__ void operator()(const f32x4 (&acc)[2][2][4][2], const Unit& u, int wr, int wc, int fr, int fq) const {
        const int row0 = u.pm * BM + wr * 64 + fr, col0 = u.pn * HALF + wc * 32 + 8 * fq;
#pragma unroll
        for (int ai = 0; ai < 2; ++ai)
#pragma unroll
            for (int m = 0; m < 4; ++m) { const int row = row0 + ai * HALF + m * 16;
                float o[8];
#pragma unroll
                for (int n = 0; n < 2; ++n)
#pragma unroll
                    for (int j = 0; j < 4; ++j) { const float g = acc[ai][0][m][n][j]; o[4 * n + j] = g * sigm(g) * acc[ai][1][m][n][j]; }
                *(u32x4*)(ACT + (size_t)row * DFF + col0) = pack8(o); }
    }
};

template <class Epi>
__device__ __forceinline__ void gemm_phase(LAS unsigned char* lds, const Gemm g, const StaticOrder& S, const Epi& E, int tid  ) {
    const int wid = __builtin_amdgcn_readfirstlane(tid >> 6), lane = tid & 63, wr = wid >> 2, wc = wid & 3, fr = lane & 15, fq = lane >> 4;
    const int K = g.K, nt = K / BK;
    unsigned voffA[2], voffB[2];
#pragma unroll
    for (int i = 0; i < 2; ++i) { int R, C; stage_rc(tid * 16 + i * 8192, R, C); const int Rb = Epi::PERM ? ((R & ~31) + perm32(R & 31)) : R;
        voffA[i] = (unsigned)(R * g.lda + C) * 2u; voffB[i] = (unsigned)(Rb * K + C) * 2u; }
    const size_t kstep = (size_t)(BK * 2);
    const size_t hstepA = (size_t)HALF * g.lda * 2, hstepB = (size_t)HALF * K * 2;
    const size_t tstepA = 2 * hstepA, tstepB = 2 * hstepB;
    const unsigned ldsw = (unsigned)wid * 1024u;
    const int aoff = lds_byte(wr * 64 + fr, fq * 8), boff = lds_byte(wc * 32 + fr, fq * 8);
#define PG8_SA(b, h) (((b) * 2 + (h)) * HTB)
#define PG8_SB(b, h) ((4 + (b) * 2 + (h)) * HTB)
#define PG8_STAGE(bufoff, gbase, voff) do { _Pragma("unroll") for (int _i = 0; _i < 2; ++_i) \
        __builtin_amdgcn_global_load_lds((const unsigned*)((const char*)(gbase) + (voff)[_i]), (LAS unsigned*)(lds + (bufoff) + ldsw + _i * 8192), 16, 0, 0); } while (0)
#define PG8_LDA(dst, b, h) do { _Pragma("unroll") for (int m = 0; m < 4; ++m) _Pragma("unroll") for (int k = 0; k < 2; ++k) dst[m][k] = *(const LAS bf16x8*)(lds + PG8_SA(b, h) + aoff + m * 2048 + k * 1024); } while (0)
#define PG8_LDB(dst, b, h) do { _Pragma("unroll") for (int n = 0; n < 2; ++n) _Pragma("unroll") for (int k = 0; k < 2; ++k) dst[n][k] = *(const LAS bf16x8*)(lds + PG8_SB(b, h) + boff + n * 2048 + k * 1024); } while (0)
#define PG8_MMA(ai, bj, At, Bt) do { __builtin_amdgcn_s_setprio(1); _Pragma("unroll") for (int m = 0; m < 4; ++m) _Pragma("unroll") for (int n = 0; n < 2; ++n) _Pragma("unroll") for (int k = 0; k < 2; ++k) \
        acc[ai][bj][m][n] = __builtin_amdgcn_mfma_f32_16x16x32_bf16(Bt[n][k], At[m][k], acc[ai][bj][m][n], 0, 0, 0); __builtin_amdgcn_s_setprio(0); } while (0)
#define PG8_WAIT_V(n) asm volatile("s_waitcnt vmcnt(" #n ")" ::: "memory")
#define PG8_WAIT_L(n) asm volatile("s_waitcnt lgkmcnt(" #n ")" ::: "memory")
#define PG8_BAR __builtin_amdgcn_s_barrier()
#define PG8_SCHED __builtin_amdgcn_sched_barrier(0)
#define PG8_AOF(u) ((const char*)g.A + (size_t)(u).pm * tstepA + (size_t)(((u).pn >> g.apn_shift) * g.apn_mul) * 2)
#define PG8_BOF(u) ((const char*)g.Bt + (size_t)(u).pn * tstepB)
    Unit cur, nxt; int ui = 0;
    if (!S.next(0, cur)) return;
    f32x4 acc[2][2][4][2];
#pragma unroll
    for (int a = 0; a < 2; ++a)
#pragma unroll
        for (int b = 0; b < 2; ++b)
#pragma unroll
            for (int m = 0; m < 4; ++m)
#pragma unroll
                for (int n = 0; n < 2; ++n) acc[a][b][m][n] = (f32x4){0.f, 0.f, 0.f, 0.f};
    bf16x8 At[4][2], B0[2][2], B1[2][2];
    const char* cA = PG8_AOF(cur); const char* cB = PG8_BOF(cur);
    PG8_STAGE(PG8_SB(0, 0), cB, voffB); PG8_STAGE(PG8_SA(0, 0), cA, voffA); PG8_STAGE(PG8_SB(0, 1), cB + hstepB, voffB); PG8_STAGE(PG8_SA(0, 1), cA + hstepA, voffA);
    if (wr == 1) PG8_BAR;
    PG8_WAIT_V(4); PG8_BAR;
    PG8_STAGE(PG8_SB(1, 0), cB + kstep, voffB); PG8_STAGE(PG8_SA(1, 0), cA + kstep, voffA); PG8_STAGE(PG8_SB(1, 1), cB + hstepB + kstep, voffB);
    PG8_WAIT_V(6); PG8_BAR;
    for (;;) {
        const bool has_next = S.next(ui + 1, nxt);
        const char* nA = has_next ? PG8_AOF(nxt) : cA; const char* nB = has_next ? PG8_BOF(nxt) : cB;
        for (int t = 0; t < nt; t += 2) {
            const bool last = (t == nt - 2);
            const char* a1 = cA + (size_t)(t + 1) * kstep;
            const char* a2 = last ? nA : cA + (size_t)(t + 2) * kstep; const char* b2 = last ? nB : cB + (size_t)(t + 2) * kstep;
            const char* a3 = a2 + kstep; const char* b3 = b2 + kstep;
            PG8_LDB(B0, 0, 0); PG8_SCHED; PG8_LDA(At, 0, 0); PG8_STAGE(PG8_SA(1, 1), a1 + hstepA, voffA);
            PG8_WAIT_L(8); PG8_BAR; PG8_WAIT_L(0); PG8_MMA(0, 0, At, B0); PG8_BAR; PG8_SCHED;
            PG8_LDB(B1, 0, 1); PG8_STAGE(PG8_SB(0, 0), b2, voffB);
            PG8_BAR; PG8_WAIT_L(0); PG8_MMA(0, 1, At, B1); PG8_BAR;
            PG8_LDA(At, 0, 1); PG8_STAGE(PG8_SA(0, 0), a2, voffA);
            PG8_BAR; PG8_WAIT_L(0); PG8_MMA(1, 0, At, B0); PG8_BAR; PG8_SCHED;
            PG8_STAGE(PG8_SB(0, 1), b2 + hstepB, voffB);
            PG8_WAIT_V(6); PG8_BAR; PG8_MMA(1, 1, At, B1); PG8_BAR;
            PG8_LDB(B0, 1, 0); PG8_SCHED; PG8_LDA(At, 1, 0); PG8_STAGE(PG8_SA(0, 1), a2 + hstepA, voffA);
            PG8_WAIT_L(8); PG8_BAR; PG8_WAIT_L(0); PG8_MMA(0, 0, At, B0); PG8_BAR; PG8_SCHED;
            PG8_LDB(B1, 1, 1); PG8_STAGE(PG8_SB(1, 0), b3, voffB);
            PG8_BAR; PG8_WAIT_L(0); PG8_MMA(0, 1, At, B1); PG8_BAR;
            PG8_LDA(At, 1, 1); PG8_STAGE(PG8_SA(1, 0), a3, voffA);
            PG8_BAR; PG8_WAIT_L(0); PG8_MMA(1, 0, At, B0); PG8_BAR; PG8_SCHED;
            PG8_STAGE(PG8_SB(1, 1), b3 + hstepB, voffB);
            PG8_WAIT_V(6); PG8_BAR; PG8_MMA(1, 1, At, B1); PG8_BAR;
        }
        E(acc, cur, wr, wc, fr, fq);
        if (!has_next) break;
#pragma unroll
        for (int a = 0; a < 2; ++a)
#pragma unroll
            for (int b = 0; b < 2; ++b)
#pragma unroll
                for (int m = 0; m < 4; ++m)
#pragma unroll
                    for (int n = 0; n < 2; ++n) acc[a][b][m][n] = (f32x4){0.f, 0.f, 0.f, 0.f};
        cur = nxt; cA = nA; cB = nB; ++ui;
    }
    PG8_WAIT_V(0);
    if (wr == 0) PG8_BAR;
    PG8_BAR;
#undef PG8_SA
#undef PG8_SB
#undef PG8_STAGE
#undef PG8_LDA
#undef PG8_LDB
#undef PG8_MMA
#undef PG8_WAIT_V
#undef PG8_WAIT_L
#undef PG8_BAR
#undef PG8_SCHED
#undef PG8_AOF
#undef PG8_BOF
}

__device__ __forceinline__ void tr_item(const float* W, int ldw, int k0, int n0, bf16_t* WT, int ldt, int drow0, int dk0, LAS float* scr, int lane) {
#pragma unroll 8
    for (int i = 0; i < 32; ++i) { const int kk = 2 * i + (lane >> 5); scr[kk * 33 + (lane & 31)] = W[(size_t)(k0 + kk) * ldw + n0 + (lane & 31)]; }
    LDS_WAIT(); asm volatile("" ::: "memory");
    const int c = lane & 7;
#pragma unroll
    for (int j = 0; j < 4; ++j) { const int n = (lane >> 3) + 8 * j; const LAS float* s = scr + (8 * c) * 33 + n;
        u32x4 o; o.x = cvt_pk_bf16(s[0 * 33], s[1 * 33]); o.y = cvt_pk_bf16(s[2 * 33], s[3 * 33]); o.z = cvt_pk_bf16(s[4 * 33], s[5 * 33]); o.w = cvt_pk_bf16(s[6 * 33], s[7 * 33]);
        *(u32x4*)(WT + (size_t)(drow0 + n) * ldt + dk0 + 8 * c) = o; }
    LDS_WAIT(); asm volatile("" ::: "memory");
}
#define TR_JOB(W, ldw, K, N, WT, ldt, DROW) do { const int nblk_ = (N) / 32, nit_ = ((K) / 64) * nblk_; \
    for (int it_ = gw; it_ < nit_; it_ += NGW) { const int kb_ = it_ / nblk_, nl = (it_ % nblk_) * 32; tr_item((W), (ldw), kb_ * 64, nl, (WT), (ldt), (DROW), kb_ * 64, scr, lane); } } while (0)

__device__ __forceinline__ void norm_rows(const float* Y, const float* Xin, float* Xout, const float* gpost, const float* gnext, bf16_t* H, int gw, int NGW, int lane) {
    for (int row = gw; row < MTOK; row += NGW) {
        const f32x4* xr = (const f32x4*)(Xin + (size_t)row * DM) + lane;
        f32x4 x[8];
#pragma unroll
        for (int j = 0; j < 8; ++j) x[j] = xr[64 * j];
        if (Y) {
            const f32x4* yr = (const f32x4*)(Y + (size_t)row * DM) + lane;
            f32x4 y[8]; float s = 0.f;
#pragma unroll
            for (int j = 0; j < 8; ++j) { y[j] = yr[64 * j]; s += (y[j][0] * y[j][0] + y[j][1] * y[j][1]) + (y[j][2] * y[j][2] + y[j][3] * y[j][3]); }
            const float rinv = rsqrtf(wave_sum(s) * (1.0f / DM) + 1e-6f);
#pragma unroll
            for (int j = 0; j < 8; ++j) { const f32x4 gp = *((const f32x4*)gpost + lane + 64 * j); x[j] = x[j] + y[j] * rinv * gp; }
        }
        if (Xout) { f32x4* xo = (f32x4*)(Xout + (size_t)row * DM) + lane;
#pragma unroll
            for (int j = 0; j < 8; ++j) xo[64 * j] = x[j]; }
        if (gnext) {
            float s = 0.f;
#pragma unroll
            for (int j = 0; j < 8; ++j) s += (x[j][0] * x[j][0] + x[j][1] * x[j][1]) + (x[j][2] * x[j][2] + x[j][3] * x[j][3]);
            const float rinv = rsqrtf(wave_sum(s) * (1.0f / DM) + 1e-6f);
            u32x2* ho = (u32x2*)(H + (size_t)row * DM) + lane;
#pragma unroll
            for (int j = 0; j < 8; ++j) { const f32x4 gn = *((const f32x4*)gnext + lane + 64 * j); const f32x4 v = x[j] * rinv * gn;
                u32x2 w; w.x = cvt_pk_bf16(v[0], v[1]); w.y = cvt_pk_bf16(v[2], v[3]); ho[64 * j] = w; }
        }
    }
}

typedef float f32x2 __attribute__((ext_vector_type(2)));
__device__ __forceinline__ void rwkv_scan(LAS unsigned char* ldsb, int wi, const bf16_t* P, const float* DEC, const bf16_t* AB, float* YRAW,
                                          const float* mu, const float* k_k, const float* k_a, int tid) {
    const int lane = tid & 63, wid = __builtin_amdgcn_readfirstlane(tid >> 6);
    const int b = wi >> 6, h = (wi >> 2) & 15, qr = wi & 3;
    constexpr int CH = 32, NCH = TSEQ / CH, ARR = CH * 64, BUF = 5 * ARR + 2 * CH * 16;
    LAS float* L = (LAS float*)ldsb;
    const int ptid = tid - 256, pt = (ptid >> 3) & 31, pc = (ptid & 7) * 8;
    const int hc = h * 64 + pc;
    const size_t mbase = (size_t)b * TSEQ;
    float mur[8], muk[8], muv[8], kkc[8], kac[8];
    u32x4 rc, rp, kc, kp, vc, vp, aw; f32x4 d0, d1;
    const u32x4 z4 = (u32x4){0u, 0u, 0u, 0u};
#define RW_LOAD(ch) do { const size_t m_ = mbase + (size_t)(ch) * CH + pt; const bf16_t* pr_ = P + m_ * EVIN_NP + 1024 + hc; const bool hp_ = ((ch) * CH + pt) > 0; \
        rc = *(const u32x4*)(pr_); kc = *(const u32x4*)(pr_ + 1024); vc = *(const u32x4*)(pr_ + 2048); \
        rp = hp_ ? *(const u32x4*)(pr_ - EVIN_NP) : z4; kp = hp_ ? *(const u32x4*)(pr_ - EVIN_NP + 1024) : z4; vp = hp_ ? *(const u32x4*)(pr_ - EVIN_NP + 2048) : z4; \
        aw = *(const u32x4*)(AB + m_ * 1024 + hc); d0 = *(const f32x4*)(DEC + m_ * 1024 + hc); d1 = *(const f32x4*)(DEC + m_ * 1024 + hc + 4); } while (0)
#define RW_PREP(B_) do { LAS float* bb_ = (B_); float r[8], k[8], v[8], a[8], t8[8]; \
        unpack8(rc, r); unpack8(rp, t8); _Pragma("unroll") for (int j = 0; j < 8; ++j) r[j] = r[j] + (t8[j] - r[j]) * mur[j]; \
        unpack8(kc, k); unpack8(kp, t8); _Pragma("unroll") for (int j = 0; j < 8; ++j) k[j] = k[j] + (t8[j] - k[j]) * muk[j]; \
        unpack8(vc, v); unpack8(vp, t8); _Pragma("unroll") for (int j = 0; j < 8; ++j) v[j] = v[j] + (t8[j] - v[j]) * muv[j]; \
        unpack8(aw, a); float kk[8]; float ss = 0.f; \
        _Pragma("unroll") for (int j = 0; j < 8; ++j) { kk[j] = k[j] * kkc[j]; ss += kk[j] * kk[j]; } \
        ss += __shfl_xor(ss, 1); ss += __shfl_xor(ss, 2); ss += __shfl_xor(ss, 4); \
        const float rn = rsqrtf(fmaxf(ss, 1e-24f)); f32x4 o0, o1; LAS float* dst; \
        dst = bb_ + pt * 64 + pc; o0 = (f32x4){r[0], r[1], r[2], r[3]}; o1 = (f32x4){r[4], r[5], r[6], r[7]}; *(LAS f32x4*)dst = o0; *(LAS f32x4*)(dst + 4) = o1; \
        dst = bb_ + ARR + pt * 64 + pc; *(LAS f32x4*)dst = d0; *(LAS f32x4*)(dst + 4) = d1; \
        _Pragma("unroll") for (int j = 0; j < 4; ++j) { o0[j] = k[j] * (1.0f + (a[j] - 1.0f) * kac[j]); o1[j] = k[4 + j] * (1.0f + (a[4 + j] - 1.0f) * kac[4 + j]); } \
        dst = bb_ + 2 * ARR + pt * 64 + pc; *(LAS f32x4*)dst = o0; *(LAS f32x4*)(dst + 4) = o1; \
        _Pragma("unroll") for (int j = 0; j < 4; ++j) { o0[j] = -kk[j] * rn; o1[j] = -kk[4 + j] * rn; } \
        dst = bb_ + 3 * ARR + pt * 64 + pc; *(LAS f32x4*)dst = o0; *(LAS f32x4*)(dst + 4) = o1; \
        _Pragma("unroll") for (int j = 0; j < 4; ++j) { o0[j] = kk[j] * rn * a[j]; o1[j] = kk[4 + j] * rn * a[4 + j]; } \
        dst = bb_ + 4 * ARR + pt * 64 + pc; *(LAS f32x4*)dst = o0; *(LAS f32x4*)(dst + 4) = o1; \
        if ((pc >> 4) == qr) { dst = bb_ + 5 * ARR + pt * 16 + (pc & 15); o0 = (f32x4){v[0], v[1], v[2], v[3]}; o1 = (f32x4){v[4], v[5], v[6], v[7]}; *(LAS f32x4*)dst = o0; *(LAS f32x4*)(dst + 4) = o1; } } while (0)
#define RW_WOUT(ch) do { if (ptid < 128) { const int t_ = ptid >> 2, j4_ = (ptid & 3) * 4; const f32x4 yv_ = *(const LAS f32x4*)(L + ((ch) & 1) * BUF + 5 * ARR + CH * 16 + t_ * 16 + j4_); \
        *(f32x4*)(YRAW + (mbase + (size_t)(ch) * CH + t_) * 1024 + h * 64 + qr * 16 + j4_) = yv_; } } while (0)
    if (wid >= 4) {
#pragma unroll
        for (int j = 0; j < 8; ++j) { mur[j] = mu[hc + j]; muk[j] = mu[1024 + hc + j]; muv[j] = mu[2048 + hc + j]; kkc[j] = k_k[hc + j]; kac[j] = k_a[hc + j]; }
        RW_LOAD(0); RW_PREP(L); RW_LOAD(1);
    }
    __syncthreads();
    const int rowl = (wid & 3) * 4 + (lane >> 4), kq = (lane & 15) * 4;
    f32x2 s01 = (f32x2){0.f, 0.f}, s23 = (f32x2){0.f, 0.f};
    for (int c = 0; c < NCH; ++c) {
        if (wid < 4) {
            const LAS float* cb = L + (c & 1) * BUF + kq;
            const LAS float* vb = L + (c & 1) * BUF + 5 * ARR + rowl;
            LAS float* yb = L + (c & 1) * BUF + 5 * ARR + CH * 16 + rowl;
            const int lj = lane & 15;
            for (int t16 = 0; t16 < CH; t16 += 16) {
                float ykeep = 0.f;
#pragma unroll
                for (int tt = 0; tt < 16; ++tt) {
                    const int t = t16 + tt;
                    const f32x4 r4 = *(const LAS f32x4*)(cb + t * 64), w4 = *(const LAS f32x4*)(cb + ARR + t * 64), k4 = *(const LAS f32x4*)(cb + 2 * ARR + t * 64);
                    const f32x4 a4 = *(const LAS f32x4*)(cb + 3 * ARR + t * 64), b4 = *(const LAS f32x4*)(cb + 4 * ARR + t * 64);
                    const float vv = vb[t * 16];
                    const f32x2 vv2 = (f32x2){vv, vv};
                    const f32x2 pa = s01 * (f32x2){a4[0], a4[1]} + s23 * (f32x2){a4[2], a4[3]};
                    const f32x2 t01 = s01 * (f32x2){w4[0], w4[1]} + vv2 * (f32x2){k4[0], k4[1]};
                    const f32x2 t23 = s23 * (f32x2){w4[2], w4[3]} + vv2 * (f32x2){k4[2], k4[3]};
                    const float sa = row16_sum(pa[0] + pa[1]);
                    const f32x2 sa2 = (f32x2){sa, sa};
                    s01 = sa2 * (f32x2){b4[0], b4[1]} + t01;
                    s23 = sa2 * (f32x2){b4[2], b4[3]} + t23;
                    const f32x2 py = s01 * (f32x2){r4[0], r4[1]} + s23 * (f32x2){r4[2], r4[3]};
                    const float y = row16_sum(py[0] + py[1]);
                    ykeep = (lj == tt) ? y : ykeep;
                }
                yb[(t16 + lj) * 16] = ykeep;
            }
        } else {
            if (c + 1 < NCH) { RW_PREP(L + ((c + 1) & 1) * BUF); if (c + 2 < NCH) RW_LOAD(c + 2); }
            if (c > 0) RW_WOUT(c - 1);
        }
        __syncthreads();
    }
    if (wid >= 4) RW_WOUT(NCH - 1);
#undef RW_LOAD
#undef RW_PREP
#undef RW_WOUT
}

__device__ __forceinline__ void rwkv_post(int gt, int NGT, const float* YRAW, const bf16_t* P, const bf16_t* AB, const bf16_t* GB, bf16_t* YCAT,
                                          const float* mu, const float* k_a, const float* r_k, const float* lnw, const float* lnb) {
    for (int it = gt; it < MTOK * 128; it += NGT) {
        const int m = it >> 7, hc = (it & 127) * 8;
        const bf16_t* pr = P + (size_t)m * EVIN_NP + 1024 + hc; const bool hp = (m & (TSEQ - 1)) != 0;
        const u32x4 z4 = (u32x4){0u, 0u, 0u, 0u};
        const u32x4 rc = *(const u32x4*)pr, kc = *(const u32x4*)(pr + 1024), vc = *(const u32x4*)(pr + 2048);
        const u32x4 rp = hp ? *(const u32x4*)(pr - EVIN_NP) : z4, kp = hp ? *(const u32x4*)(pr - EVIN_NP + 1024) : z4, vp = hp ? *(const u32x4*)(pr - EVIN_NP + 2048) : z4;
        const u32x4 aw = *(const u32x4*)(AB + (size_t)m * 1024 + hc), gw_ = *(const u32x4*)(GB + (size_t)m * 1024 + hc);
        const f32x4 y0 = *(const f32x4*)(YRAW + (size_t)m * 1024 + hc), y1 = *(const f32x4*)(YRAW + (size_t)m * 1024 + hc + 4);
        float r[8], k[8], v[8], a[8], gg[8], t8[8], y[8];
        unpack8(rc, r); unpack8(rp, t8);
#pragma unroll
        for (int j = 0; j < 8; ++j) r[j] = r[j] + (t8[j] - r[j]) * mu[hc + j];
        unpack8(kc, k); unpack8(kp, t8);
#pragma unroll
        for (int j = 0; j < 8; ++j) k[j] = k[j] + (t8[j] - k[j]) * mu[1024 + hc + j];
        unpack8(vc, v); unpack8(vp, t8);
#pragma unroll
        for (int j = 0; j < 8; ++j) v[j] = v[j] + (t8[j] - v[j]) * mu[2048 + hc + j];
        unpack8(aw, a); unpack8(gw_, gg);
#pragma unroll
        for (int j = 0; j < 4; ++j) { y[j] = y0[j]; y[4 + j] = y1[j]; }
        float s = 0.f, bo = 0.f;
#pragma unroll
        for (int j = 0; j < 8; ++j) { s += y[j]; const float kx = k[j] * (1.0f + (a[j] - 1.0f) * k_a[hc + j]); bo += r[j] * kx * r_k[hc + j]; }
        s += __shfl_xor(s, 1); s += __shfl_xor(s, 2); s += __shfl_xor(s, 4);
        bo += __shfl_xor(bo, 1); bo += __shfl_xor(bo, 2); bo += __shfl_xor(bo, 4);
        const float mean = s * (1.0f / 64.0f);
        float q = 0.f;
#pragma unroll
        for (int j = 0; j < 8; ++j) { y[j] -= mean; q += y[j] * y[j]; }
        q += __shfl_xor(q, 1); q += __shfl_xor(q, 2); q += __shfl_xor(q, 4);
        const float rstd = rsqrtf(q * (1.0f / 64.0f) + 64e-5f);
        float o[8];
#pragma unroll
        for (int j = 0; j < 8; ++j) o[j] = (y[j] * rstd * lnw[hc + j] + lnb[hc + j] + bo * v[j]) * gg[j];
        *(u32x4*)(YCAT + (size_t)m * DM + 1024 + hc) = pack8(o);
    }
}

__device__ __forceinline__ void s5_scan(LAS unsigned char* ldsb, int pair, const bf16_t* P, bf16_t* Y5, const float* lam_re, const float* lam_im, const float* log_dt,
                                        const float* b_re, const float* b_im, const float* c_re, const float* c_im, const float* dsk, int tid) {
    const int lane = tid & 63, wid = __builtin_amdgcn_readfirstlane(tid >> 6), fr = lane & 15, fq = lane >> 4;
    const int b = pair >> 6, g = pair & 63;
    LAS float* BR = (LAS float*)ldsb;
    LAS float* BI = BR + 64 * 68;
    LAS bf16_t* SR = (LAS bf16_t*)(BI + 64 * 68);
    LAS bf16_t* SI = SR + 64 * 72;
    const float dt = __expf(log_dt[g]);
    const int tt = wid & 3, ri = wid >> 2;
    bf16x8 bfrag[4];
#pragma unroll
    for (int pt = 0; pt < 4; ++pt) {
        const int p = pt * 16 + fr;
        const float lr = lam_re[g * 64 + p], li = lam_im[g * 64 + p];
        const float mag = __expf(lr * dt), ang = li * dt;
        const float are = mag * cosf(ang), aim = mag * sinf(ang);
        const float den = lr * lr + li * li, nr = are - 1.0f, ni = aim;
        const float gre = (nr * lr + ni * li) / den, gim = (ni * lr - nr * li) / den;
        float o[8];
#pragma unroll
        for (int e = 0; e < 8; ++e) {
            float val = 0.f;
            if (fq < 2) { const float br = b_re[(size_t)(g * 64 + p) * 16 + fq * 8 + e], bi = b_im[(size_t)(g * 64 + p) * 16 + fq * 8 + e];
                val = ri ? (gre * bi + gim * br) : (gre * br - gim * bi); }
            o[e] = val;
        }
        const u32x4 w = pack8(o); bfrag[pt] = __builtin_bit_cast(bf16x8, w);
    }
    float are_, aim_;
    { const float lr = lam_re[g * 64 + lane], li = lam_im[g * 64 + lane]; const float mag = __expf(lr * dt), ang = li * dt; are_ = mag * cosf(ang); aim_ = mag * sinf(ang); }
    bf16x8 cfrag[4];
#pragma unroll
    for (int kk = 0; kk < 4; ++kk) {
        float o[8];
#pragma unroll
        for (int e = 0; e < 8; ++e) { const int p = (kk & 1) * 32 + fq * 8 + e; o[e] = (kk < 2) ? c_re[(size_t)(g * 16 + fr) * 64 + p] : -c_im[(size_t)(g * 16 + fr) * 64 + p]; }
        const u32x4 w = pack8(o); cfrag[kk] = __builtin_bit_cast(bf16x8, w);
    }
    const f32x4 d4 = *(const f32x4*)(dsk + g * 16 + fq * 4);
    float sre = 0.f, sim = 0.f;
    const size_t m0 = (size_t)b * TSEQ;
    const u32x4 z4 = (u32x4){0u, 0u, 0u, 0u};
    u32x4 ucur = (fq < 2) ? *(const u32x4*)(P + (m0 + tt * 16 + fr) * EVIN_NP + g * 16 + fq * 8) : z4;
    for (int ch = 0; ch < TSEQ / 64; ++ch) {
        const size_t mc = m0 + (size_t)ch * 64;
        u32x4 unext = z4;
        if (ch + 1 < TSEQ / 64 && fq < 2) unext = *(const u32x4*)(P + (mc + 64 + tt * 16 + fr) * EVIN_NP + g * 16 + fq * 8);
        u32x2 usk = (u32x2){0u, 0u};
        if (wid < 4) usk = *(const u32x2*)(P + (mc + wid * 16 + fr) * EVIN_NP + g * 16 + fq * 4);
        {
            const bf16x8 ufrag = __builtin_bit_cast(bf16x8, ucur);
            LAS float* dst = (ri ? BI : BR) + (tt * 16 + fq * 4) * 68 + fr;
#pragma unroll
            for (int pt = 0; pt < 4; ++pt) {
                f32x4 d = (f32x4){0.f, 0.f, 0.f, 0.f};
                d = __builtin_amdgcn_mfma_f32_16x16x32_bf16(ufrag, bfrag[pt], d, 0, 0, 0);
#pragma unroll
                for (int jj = 0; jj < 4; ++jj) dst[jj * 68 + pt * 16] = d[jj];
            }
        }
        __syncthreads();
        if (wid == 0) {
#pragma unroll
            for (int t8 = 0; t8 < 8; ++t8) {
                float xr[8], xi[8];
#pragma unroll
                for (int i = 0; i < 8; ++i) { xr[i] = BR[(t8 * 8 + i) * 68 + lane]; xi[i] = BI[(t8 * 8 + i) * 68 + lane]; }
#pragma unroll
                for (int i = 0; i < 8; ++i) {
                    const float nre = are_ * sre - aim_ * sim + xr[i], nim = are_ * sim + aim_ * sre + xi[i];
                    sre = nre; sim = nim;
                    const unsigned w = cvt_pk_bf16(sre, sim);
                    SR[(t8 * 8 + i) * 72 + lane] = (bf16_t)(w & 0xffffu); SI[(t8 * 8 + i) * 72 + lane] = (bf16_t)(w >> 16);
                }
            }
        }
        __syncthreads();
        if (wid < 4) {
            f32x4 d = (f32x4){0.f, 0.f, 0.f, 0.f};
#pragma unroll
            for (int kk = 0; kk < 4; ++kk) {
                const LAS bf16_t* src = ((kk < 2) ? SR : SI) + (wid * 16 + fr) * 72 + (kk & 1) * 32 + fq * 8;
                const bf16x8 sfrag = *(const LAS bf16x8*)src;
                d = __builtin_amdgcn_mfma_f32_16x16x32_bf16(cfrag[kk], sfrag, d, 0, 0, 0);
            }
            const float u0 = bflo(usk.x), u1 = bfhi(usk.x), u2 = bflo(usk.y), u3 = bfhi(usk.y);
            const float y0 = gelu_t(d[0] + d4[0] * u0), y1 = gelu_t(d[1] + d4[1] * u1), y2 = gelu_t(d[2] + d4[2] * u2), y3 = gelu_t(d[3] + d4[3] * u3);
            u32x2 w; w.x = cvt_pk_bf16(y0, y1); w.y = cvt_pk_bf16(y2, y3);
            *(u32x2*)(Y5 + (mc + wid * 16 + fr) * 1024 + g * 16 + fq * 4) = w;
        }
        ucur = unext;
    }
}

__device__ __forceinline__ void lru_scan(LAS unsigned char* ldsb, int wi, const float* AA, const float* BX, const bf16_t* GATE, bf16_t* HG, int tid) {
    const int c = tid & 31, seg = tid >> 5;
    const int b = wi >> 6, ch = (wi & 63) * 32 + c;
    LAS float* SA = (LAS float*)ldsb; LAS float* SH = SA + 512;
    const size_t base = ((size_t)b * TSEQ + (size_t)seg * 256) * DM + ch;
    float Ap = 1.f, h = 0.f;
#pragma unroll 8
    for (int t = 0; t < 256; ++t) { const float a = AA[base + (size_t)t * DM], x = BX[base + (size_t)t * DM]; h = a * h + x; Ap *= a; }
    SA[seg * 32 + c] = Ap; SH[seg * 32 + c] = h;
    __syncthreads();
    float hin = 0.f;
    for (int s = 0; s < seg; ++s) hin = SA[s * 32 + c] * hin + SH[s * 32 + c];
    h = hin;
#pragma unroll 8
    for (int t = 0; t < 256; ++t) { const float a = AA[base + (size_t)t * DM], x = BX[base + (size_t)t * DM]; h = a * h + x;
        const float gt = __uint_as_float((unsigned)GATE[base + (size_t)t * DM] << 16);
        HG[base + (size_t)t * DM] = (bf16_t)(cvt_pk_bf16(h * gt, 0.f) & 0xffffu); }
    __syncthreads();
}

typedef __attribute__((address_space(4))) const Params CParams;
#define KP() ({ CParams* q_ = pp; asm volatile("" : "+s"(q_)); q_; })
#define PIN(i) (KP()->in[i])
#define ws (KP()->ws)
#define XRES (KP()->out)
#define H ((bf16_t*)(ws + WS_H))
#define P ((bf16_t*)(ws + WS_P))
#define YMIX ((float*)(ws + WS_YMIX))
#define ACT ((bf16_t*)(ws + WS_ACT))
#define tid ({ int t_ = wave_s * 64 + (int)__builtin_amdgcn_mbcnt_hi(~0u, __builtin_amdgcn_mbcnt_lo(~0u, 0u)); asm volatile("" : "+v"(t_)); t_; })
#define lane (tid & 63)
#define wid (__builtin_amdgcn_readfirstlane(tid >> 6))
#define gw (bid * NWAVES + wid)
#define gt (bid * NTHREADS + tid)

template <int layer>
__device__ __forceinline__ void layer_body(CParams* pp, const int wave_s, LAS unsigned char* lds, cg::grid_group& grid) {
    const int G = gridDim.x, bid = blockIdx.x;
    const int NGW = G * NWAVES, NGT = G * NTHREADS;
        const int li = layer >> 1;
        if ((layer & 1) == 0) {
            const float* mu = PIN(2) + (size_t)li * 3360;
            { Gemm g{H, (const bf16_t*)(ws + WS_EVIN + li * SZ_EVIN), DM, DM, 0, 0}; StaticOrder S; S.init(MTOK, EVIN_NP, G, bid);
              EpiBf16 E{P, EVIN_NP}; gemm_phase<EpiBf16>(lds, g, S, E, tid); }
            grid.sync();
            {
                bf16_t* LRA = (bf16_t*)(ws + WS_LRACT);
                for (int i = gt; i < MTOK * LRK; i += NGT) {
                    const int m = i / LRK, j = i % LRK; float v = 0.f;
                    if (j < 288) { const int col = 4096 + j; const float z = __uint_as_float((unsigned)P[(size_t)m * EVIN_NP + col] << 16);
                        const float zp = (m & (TSEQ - 1)) ? __uint_as_float((unsigned)P[(size_t)(m - 1) * EVIN_NP + col] << 16) : 0.f;
                        const float zz = z + (zp - z) * mu[col - 1024];
                        v = (j < 64) ? (2.0f * sigm(2.0f * zz) - 1.0f) : ((j < 128) ? zz : sigm(zz)); }
                    LRA[i] = (bf16_t)(cvt_pk_bf16(v, 0.f) & 0xffffu);
                }
            }
            grid.sync();
            { Gemm g{(const bf16_t*)(ws + WS_LRACT), (const bf16_t*)(ws + WS_LR + li * SZ_LR), LRK, LRK, 0, 0}; StaticOrder S; S.init(MTOK, 3072, G, bid);
              EpiLR E{(float*)(ws + WS_DEC), (bf16_t*)(ws + WS_AB), (bf16_t*)(ws + WS_GB), PIN(12) + li * 1024, PIN(14) + li * 1024}; gemm_phase<EpiLR>(lds, g, S, E, tid); }
            grid.sync();
            for (int wi = bid; wi < 256; wi += G) {
                if (wi < 128) rwkv_scan(lds, wi, P, (const float*)(ws + WS_DEC), (const bf16_t*)(ws + WS_AB), (float*)(ws + WS_YRAW), mu, PIN(17) + li * 1024, PIN(18) + li * 1024, tid);
                else s5_scan(lds, wi - 128, P, (bf16_t*)(ws + WS_Y5), PIN(3) + li * 4096, PIN(4) + li * 4096, PIN(5) + li * 64,
                             PIN(6) + (size_t)li * 65536, PIN(7) + (size_t)li * 65536, PIN(8) + (size_t)li * 65536, PIN(9) + (size_t)li * 65536, PIN(10) + li * 1024, tid);
                __syncthreads();
            }
            grid.sync();
            {
                Gemm g{(const bf16_t*)(ws + WS_Y5), (const bf16_t*)(ws + WS_GLU + li * SZ_GLU), 1024, 1024, 0, 0}; StaticOrder S; S.init(MTOK, 1024, G, bid);
                EpiGLU E{(const bf16_t*)(ws + WS_Y5), (bf16_t*)(ws + WS_YCAT)}; gemm_phase<EpiGLU>(lds, g, S, E, tid);
                if (bid >= 128 || G < 256) {
                    const int nb = (G < 256) ? G : (G - 128), b0 = (G < 256) ? bid : (bid - 128);
                    rwkv_post(b0 * NTHREADS + tid, nb * NTHREADS, (const float*)(ws + WS_YRAW), P, (const bf16_t*)(ws + WS_AB), (const bf16_t*)(ws + WS_GB), (bf16_t*)(ws + WS_YCAT),
                              mu, PIN(18) + li * 1024, PIN(19) + li * 1024, PIN(20) + li * 1024, PIN(21) + li * 1024);
                }
            }
            grid.sync();
            { Gemm g{(const bf16_t*)(ws + WS_YCAT), (const bf16_t*)(ws + WS_EVOUT + li * SZ_SQ), DM, DM, 0, 0}; StaticOrder S; S.init(MTOK, DM, G, bid);
              EpiF32 E{YMIX, DM}; gemm_phase<EpiF32>(lds, g, S, E, tid); }
            grid.sync();
        } else {
            bf16_t* GATE = (bf16_t*)(ws + WS_GATE); bf16_t* XB = (bf16_t*)(ws + WS_XB); bf16_t* XC = (bf16_t*)(ws + WS_XC);
            { Gemm g{H, (const bf16_t*)(ws + WS_ODIN + li * SZ_ODIN), DM, DM, 0, 0}; StaticOrder S; S.init(MTOK, 4096, G, bid);
              EpiOddIn E{GATE, XB}; gemm_phase<EpiOddIn>(lds, g, S, E, tid); }
            grid.sync();
            {
                const float* cw = PIN(24) + (size_t)li * 4 * DM; const float* cb = PIN(25) + (size_t)li * DM;
                for (int i = gt; i < MTOK * (DM / 8); i += NGT) {
                    const int m = i >> 8, c8 = (i & 255) * 8, t = m & (TSEQ - 1);
                    float acc[8];
#pragma unroll
                    for (int j = 0; j < 8; ++j) acc[j] = cb[c8 + j];
#pragma unroll
                    for (int q = 0; q < 4; ++q) {
                        if (t - 3 + q >= 0) { const u32x4 xw = *(const u32x4*)(XB + (size_t)(m - 3 + q) * DM + c8); float xv[8]; unpack8(xw, xv);
#pragma unroll
                            for (int j = 0; j < 8; ++j) acc[j] += cw[q * DM + c8 + j] * xv[j]; }
                    }
                    *(u32x4*)(XC + (size_t)m * DM + c8) = pack8(acc);
                }
            }
            grid.sync();
            { Gemm g{XC, (const bf16_t*)(ws + WS_GATES + li * SZ_GATES), DM, 256, 1, 256}; StaticOrder S; S.init(MTOK, 4096, G, bid);
              EpiGates E{XC, (float*)(ws + WS_AA), (float*)(ws + WS_BX), PIN(27) + li * DM, PIN(29) + li * DM, PIN(30) + li * DM}; gemm_phase<EpiGates>(lds, g, S, E, tid); }
            grid.sync();
            for (int wi = bid; wi < 128; wi += G) lru_scan(lds, wi, (const float*)(ws + WS_AA), (const float*)(ws + WS_BX), GATE, XB  , tid);
            grid.sync();
            { Gemm g{XB  , (const bf16_t*)(ws + WS_ODOUT + li * SZ_SQ), DM, DM, 0, 0}; StaticOrder S; S.init(MTOK, DM, G, bid);
              EpiF32 E{YMIX, DM}; gemm_phase<EpiF32>(lds, g, S, E, tid); }
            grid.sync();
        }
        norm_rows(YMIX, XRES, XRES, PIN(36) + layer * DM, PIN(37) + layer * DM, H, gw, NGW, lane);
        grid.sync();
        { Gemm g{H, (const bf16_t*)(ws + WS_GU + layer * SZ_GU), DM, DM, 0, 0}; StaticOrder S; S.init(MTOK, 2 * DFF, G, bid);
          EpiGU E{ACT}; gemm_phase<EpiGU>(lds, g, S, E, tid); }
        grid.sync();
        { Gemm g{ACT, (const bf16_t*)(ws + WS_DN + layer * SZ_DN), DFF, DFF, 0, 0}; StaticOrder S; S.init(MTOK, DM, G, bid);
          EpiF32 E{YMIX, DM}; gemm_phase<EpiF32>(lds, g, S, E, tid); }
        grid.sync();
        norm_rows(YMIX, XRES, XRES, PIN(38) + layer * DM, (layer < 3) ? (PIN(35) + (layer + 1) * DM) : nullptr, H, gw, NGW, lane);
        if (layer < 3) grid.sync();
}

__global__ void __launch_bounds__(NTHREADS) mega_fwd(Params p) {
    extern __shared__ __attribute__((aligned(16))) unsigned char lds_raw[];
    LAS unsigned char* lds = (LAS unsigned char*)lds_raw;
    cg::grid_group grid = cg::this_grid();
    CParams* pp = (CParams*)__builtin_amdgcn_kernarg_segment_ptr();
    const int wave_s = __builtin_amdgcn_readfirstlane(threadIdx.x >> 6);
    const int G = gridDim.x, bid = blockIdx.x;
    const int NGW = G * NWAVES, NGT = G * NTHREADS;

    {
        LAS float* scr = (LAS float*)(lds + wid * 8448);
        for (int e = 0; e < 2; ++e) {
            bf16_t* wevin = (bf16_t*)(ws + WS_EVIN + e * SZ_EVIN);
            TR_JOB(PIN(1) + (size_t)e * DM * EVIN_N, EVIN_N, DM, EVIN_N, wevin, DM, nl);
            for (int i = gt; i < (EVIN_NP - EVIN_N) * DM / 8; i += NGT) *(u32x4*)(wevin + (size_t)EVIN_N * DM + (size_t)i * 8) = (u32x4){0u, 0u, 0u, 0u};
            TR_JOB(PIN(11) + (size_t)e * 1024 * 1024, 1024, 1024, 1024, (bf16_t*)(ws + WS_GLU + e * SZ_GLU), 1024, nl);
            TR_JOB(PIN(22) + (size_t)e * DM * DM, DM, DM, DM, (bf16_t*)(ws + WS_EVOUT + e * SZ_SQ), DM, nl);
            {
                bf16_t* wlr = (bf16_t*)(ws + WS_LR + e * SZ_LR);
                const float* w2 = PIN(13) + (size_t)e * 64 * 1024; const float* a2 = PIN(15) + (size_t)e * 64 * 1024; const float* g2 = PIN(16) + (size_t)e * 160 * 1024;
                for (int i = gt; i < 3072 * (LRK / 8); i += NGT) {
                    const int n = i / (LRK / 8), k8 = (i % (LRK / 8)) * 8, type = n >> 10, nn = n & 1023;
                    float o[8];
#pragma unroll
                    for (int j = 0; j < 8; ++j) { const int k = k8 + j; float v = 0.f;
                        if (type == 0) { if (k < 64) v = w2[(size_t)k * 1024 + nn]; }
                        else if (type == 1) { if (k >= 64 && k < 128) v = a2[(size_t)(k - 64) * 1024 + nn]; }
                        else { if (k >= 128 && k < 288) v = g2[(size_t)(k - 128) * 1024 + nn]; }
                        o[j] = v; }
                    *(u32x4*)(wlr + (size_t)n * LRK + k8) = pack8(o);
                }
            }
        }
        for (int o = 0; o < 2; ++o) {
            TR_JOB(PIN(23) + (size_t)o * DM * 4096, 4096, DM, 4096, (bf16_t*)(ws + WS_ODIN + o * SZ_ODIN), DM, nl);
            TR_JOB(PIN(31) + (size_t)o * DM * DM, DM, DM, DM, (bf16_t*)(ws + WS_ODOUT + o * SZ_SQ), DM, nl);
            bf16_t* wg = (bf16_t*)(ws + WS_GATES + o * SZ_GATES);
            for (int it = gw; it < 16 * 32; it += NGW) {
                const int job = it >> 5, sub = it & 31, blk = job >> 1, ri = job & 1, kb = sub >> 3, nl = (sub & 7) * 32;
                const float* W = (ri ? PIN(28) : PIN(26)) + (size_t)(o * 8 + blk) * 65536;
                tr_item(W, 256, kb * 64, nl, wg, 256, (2 * blk + (nl >> 7)) * 256 + ri * 128 + (nl & 127), kb * 64, scr, lane);
            }
        }
        for (int l = 0; l < 4; ++l) {
            bf16_t* wgu = (bf16_t*)(ws + WS_GU + l * SZ_GU);
            TR_JOB(PIN(32) + (size_t)l * DM * DFF, DFF, DM, DFF, wgu, DM, (nl >> 7) * 256 + (nl & 127));
            TR_JOB(PIN(33) + (size_t)l * DM * DFF, DFF, DM, DFF, wgu, DM, (nl >> 7) * 256 + 128 + (nl & 127));
            TR_JOB(PIN(34) + (size_t)l * DFF * DM, DM, DFF, DM, (bf16_t*)(ws + WS_DN + l * SZ_DN), DFF, nl);
        }
        norm_rows(nullptr, PIN(0), XRES, nullptr, PIN(35), H, gw, NGW, lane);
    }
    grid.sync();

    layer_body<0>(pp, wave_s, lds, grid);
    layer_body<1>(pp, wave_s, lds, grid);
    layer_body<2>(pp, wave_s, lds, grid);
    layer_body<3>(pp, wave_s, lds, grid);
}

#undef KP
#undef PIN
#undef ws
#undef XRES
#undef H
#undef P
#undef YMIX
#undef ACT
#undef tid
#undef lane
#undef wid
#undef gw
#undef gt

extern "C" void kernel_launch(void* const* d_in, const int* in_sizes, int n_in, void* d_out, int out_size, void* d_ws, size_t ws_size, hipStream_t stream) {
    static int grid = 0;
    if (grid == 0) {
        if (n_in != 39 || out_size != MTOK * DM || ws_size < WS_END) { fprintf(stderr, "kernel_launch: unexpected shapes (n_in %d out %d ws %zu need %zu)\n", n_in, out_size, ws_size, (size_t)WS_END); grid = -1; return; }
        int dev = 0, cus = 0, per_cu = 0;
        (void)hipGetDevice(&dev);
        (void)hipDeviceGetAttribute(&cus, hipDeviceAttributeMultiprocessorCount, dev);
        if (hipFuncSetAttribute((const void*)mega_fwd, hipFuncAttributeMaxDynamicSharedMemorySize, LDS_BYTES) != hipSuccess) { fprintf(stderr, "kernel_launch: hipFuncSetAttribute failed\n"); grid = -1; return; }
        if (hipOccupancyMaxActiveBlocksPerMultiprocessor(&per_cu, (const void*)mega_fwd, NTHREADS, LDS_BYTES) != hipSuccess || per_cu < 1) { fprintf(stderr, "kernel_launch: occupancy query gave %d\n", per_cu); per_cu = 1; }
        (void)hipGetLastError();
        grid = cus * 1;
    }
    if (grid < 0) return;
    Params p{};
    for (int i = 0; i < 39; ++i) p.in[i] = (const float*)d_in[i];
    p.out = (float*)d_out; p.ws = (unsigned char*)d_ws;
    void* args[] = {&p};
    hipError_t e = hipLaunchCooperativeKernel((const void*)mega_fwd, dim3(grid), dim3(NTHREADS), args, LDS_BYTES, stream);
    if (e != hipSuccess) fprintf(stderr, "cooperative launch failed: %s (grid %d)\n", hipGetErrorString(e), grid);
}
```

```cpp
#include <hip/hip_runtime.h>
#include <hip/hip_cooperative_groups.h>
#include <cstdio>
namespace cg = cooperative_groups;

#define LAS __attribute__((address_space(3)))
typedef unsigned short bf16_t;
typedef short bf16x8 __attribute__((ext_vector_type(8)));
typedef float f32x4 __attribute__((ext_vector_type(4)));
typedef unsigned u32x4 __attribute__((ext_vector_type(4)));
typedef unsigned u32x2 __attribute__((ext_vector_type(2)));

constexpr int MTOK = 8192, TSEQ = 4096, DM = 2048, DFF = 5632;
constexpr int EVIN_N = 4384, EVIN_NP = 4608, LRK = 384;
constexpr int NTHREADS = 512, NWAVES = 8;
constexpr int BM = 256, BK = 64, HALF = 128, HTB = HALF * BK * 2, STAGE_BYTES = 8 * HTB, NXCD = 8, WGM = 8;
constexpr int LDS_BYTES = STAGE_BYTES + 64;

constexpr size_t al256(size_t x) { return (x + 255) & ~(size_t)255; }
constexpr size_t SZ_EVIN = (size_t)EVIN_NP * DM * 2, SZ_GLU = (size_t)1024 * 1024 * 2, SZ_LR = (size_t)3072 * LRK * 2, SZ_SQ = (size_t)DM * DM * 2;
constexpr size_t SZ_ODIN = (size_t)4096 * DM * 2, SZ_GATES = (size_t)4096 * 256 * 2, SZ_GU = (size_t)2 * DFF * DM * 2, SZ_DN = (size_t)DM * DFF * 2;
constexpr size_t WS_EVIN = 0;
constexpr size_t WS_GLU = WS_EVIN + 2 * SZ_EVIN;
constexpr size_t WS_LR = WS_GLU + 2 * SZ_GLU;
constexpr size_t WS_EVOUT = WS_LR + 2 * SZ_LR;
constexpr size_t WS_ODIN = WS_EVOUT + 2 * SZ_SQ;
constexpr size_t WS_GATES = WS_ODIN + 2 * SZ_ODIN;
constexpr size_t WS_ODOUT = WS_GATES + 2 * SZ_GATES;
constexpr size_t WS_GU = WS_ODOUT + 2 * SZ_SQ;
constexpr size_t WS_DN = WS_GU + 4 * SZ_GU;
constexpr size_t WS_H = WS_DN + 4 * SZ_DN;
constexpr size_t WS_P = WS_H + (size_t)MTOK * DM * 2;
constexpr size_t WS_YMIX = WS_P + (size_t)MTOK * EVIN_NP * 2;
constexpr size_t WS_ACT = WS_YMIX + (size_t)MTOK * DM * 4;
constexpr size_t WS_MIX2 = WS_ACT + (size_t)MTOK * DFF * 2;
constexpr size_t WS_BAR = WS_MIX2 + (size_t)MTOK * DM * 4;
constexpr size_t WS_END = WS_BAR + 16384;
constexpr size_t WS_LRACT = WS_ACT;
constexpr size_t WS_DEC = WS_LRACT + (size_t)MTOK * LRK * 2;
constexpr size_t WS_AB = WS_DEC + (size_t)MTOK * 1024 * 4;
constexpr size_t WS_GB = WS_AB + (size_t)MTOK * 1024 * 2;
constexpr size_t WS_Y5 = WS_GB + (size_t)MTOK * 1024 * 2;
static_assert(WS_Y5 + (size_t)MTOK * 1024 * 2 <= WS_MIX2, "even temporaries overflow ACT");
constexpr size_t WS_YRAW = WS_MIX2;
constexpr size_t WS_YCAT = WS_MIX2 + (size_t)MTOK * 1024 * 4;
constexpr size_t WS_GATE = WS_P;
constexpr size_t WS_XB = WS_P + (size_t)MTOK * DM * 2;
constexpr size_t WS_XC = WS_YMIX;
constexpr size_t WS_AA = WS_ACT;
constexpr size_t WS_BX = WS_MIX2;

struct Params { const float* in[39]; float* out; unsigned char* ws; };

__device__ __forceinline__ unsigned cvt_pk_bf16(float lo, float hi) { unsigned r; asm volatile("v_cvt_pk_bf16_f32 %0, %1, %2" : "=v"(r) : "v"(lo), "v"(hi)); return r; }
__device__ __forceinline__ float bflo(unsigned w) { return __uint_as_float(w << 16); }
__device__ __forceinline__ float bfhi(unsigned w) { return __uint_as_float(w & 0xffff0000u); }
__device__ __forceinline__ float sigm(float x) { return __builtin_amdgcn_rcpf(1.0f + __expf(-x)); }
__device__ __forceinline__ float gelu_t(float x) { return x * sigm(1.5957691216057308f * (x + 0.044715f * x * x * x)); }
__device__ __forceinline__ float softplus_f(float z) { return fmaxf(z, 0.f) + __logf(1.0f + __expf(-fabsf(z))); }
__device__ __forceinline__ void unpack8(const u32x4 w, float (&f)[8]) {
    f[0] = bflo(w.x); f[1] = bfhi(w.x); f[2] = bflo(w.y); f[3] = bfhi(w.y); f[4] = bflo(w.z); f[5] = bfhi(w.z); f[6] = bflo(w.w); f[7] = bfhi(w.w);
}
__device__ __forceinline__ u32x4 pack8(const float (&f)[8]) { u32x4 w; w.x = cvt_pk_bf16(f[0], f[1]); w.y = cvt_pk_bf16(f[2], f[3]); w.z = cvt_pk_bf16(f[4], f[5]); w.w = cvt_pk_bf16(f[6], f[7]); return w; }
__device__ __forceinline__ float wave_sum(float v) {
#pragma unroll
    for (int o = 1; o < 64; o <<= 1) v += __shfl_xor(v, o);
    return v;
}
template <int CTRL> __device__ __forceinline__ float dpp_f(float x) { return __int_as_float(__builtin_amdgcn_update_dpp(0, __float_as_int(x), CTRL, 0xf, 0xf, true)); }
__device__ __forceinline__ float row16_sum(float x) {
    x += dpp_f<0xB1>(x);
    x += dpp_f<0x4E>(x);
    x += dpp_f<0x141>(x);
    x += dpp_f<0x140>(x);
    return x;
}
#define LDS_WAIT() asm volatile("s_waitcnt lgkmcnt(0)" ::: "memory")

__device__ __forceinline__ int lds_byte(int r, int c) { const int st = (r >> 4) * 2 + (c >> 5), rr = r & 15, cc = c & 31, ob = rr * 64 + cc * 2; return st * 1024 + (ob ^ (((ob >> 9) & 1) << 5)); }
__device__ __forceinline__ void stage_rc(int b, int& R, int& C) { const int st = b / 1024, sb = b % 1024, swz = sb ^ (((sb >> 9) & 1) << 5); R = (st >> 1) * 16 + swz / 64; C = (st & 1) * 32 + (swz % 64) / 2; }
__device__ __forceinline__ int perm32(int rho) { const int n = rho >> 4, i = rho & 15; return 8 * (i >> 2) + 4 * n + (i & 3); }

struct Unit { int pm, pn; };
struct Gemm { const bf16_t* A; const bf16_t* Bt; int lda, K, apn_shift, apn_mul; };
struct StaticOrder {
    int nM, nN, nwg, G, c;
    __device__ void init(int M, int N, int G_, int c_) { nM = M / BM; nN = N / BM; nwg = nM * nN; G = G_; c = c_; }
    __device__ bool next(int i, Unit& u) const {
        const long L = (long)i * G + c; if (L >= nwg) return false;
        int wgid = (int)L; { const int q = nwg / NXCD, r = nwg % NXCD, xcd = wgid % NXCD, off = wgid / NXCD; wgid = (xcd < r ? xcd * (q + 1) : r * (q + 1) + (xcd - r) * q) + off; }
        const int nig = WGM * nN, gid = wgid / nig, fm = gid * WGM, gsz = (nM - fm) < WGM ? (nM - fm) : WGM;
        u.pm = fm + ((wgid % nig) % gsz); u.pn = (wgid % nig) / gsz; return true;
    }
};

struct EpiF32 {
    static constexpr bool PERM = false;
    float* C; int ldc;
    __device__ __forceinline__ void operator()(const f32x4 (&acc)[2][2][4][2], const Unit& u, int wr, int wc, int fr, int fq) const {
        const int row0 = u.pm * BM + wr * 64 + fr, col0 = u.pn * BM + wc * 32 + 4 * fq;
#pragma unroll
        for (int ai = 0; ai < 2; ++ai)
#pragma unroll
            for (int m = 0; m < 4; ++m) { float* rowp = C + (size_t)(row0 + ai * HALF + m * 16) * ldc + col0;
#pragma unroll
                for (int bj = 0; bj < 2; ++bj)
#pragma unroll
                    for (int n = 0; n < 2; ++n) *(f32x4*)(rowp + bj * HALF + n * 16) = acc[ai][bj][m][n]; }
    }
};
struct EpiBf16 {
    static constexpr bool PERM = true;
    bf16_t* O; int ldc;
    __device__ __forceinline__ void operator()(const f32x4 (&acc)[2][2][4][2], const Unit& u, int wr, int wc, int fr, int fq) const {
        const int row0 = u.pm * BM + wr * 64 + fr, col0 = u.pn * BM + wc * 32 + 8 * fq;
#pragma unroll
        for (int ai = 0; ai < 2; ++ai)
#pragma unroll
            for (int m = 0; m < 4; ++m) { bf16_t* rowp = O + (size_t)(row0 + ai * HALF + m * 16) * ldc + col0;
#pragma unroll
                for (int bj = 0; bj < 2; ++bj) { const f32x4 v0 = acc[ai][bj][m][0], v1 = acc[ai][bj][m][1];
                    u32x4 w; w.x = cvt_pk_bf16(v0[0], v0[1]); w.y = cvt_pk_bf16(v0[2], v0[3]); w.z = cvt_pk_bf16(v1[0], v1[1]); w.w = cvt_pk_bf16(v1[2], v1[3]);
                    *(u32x4*)(rowp + bj * HALF) = w; } }
    }
};
struct EpiOddIn {
    static constexpr bool PERM = true;
    bf16_t* GATE; bf16_t* XB;
    __device__ __forceinline__ void operator()(const f32x4 (&acc)[2][2][4][2], const Unit& u, int wr, int wc, int fr, int fq) const {
        const bool isg = u.pn < 8; bf16_t* base = isg ? GATE : XB;
        const int row0 = u.pm * BM + wr * 64 + fr, col0 = (u.pn & 7) * BM + wc * 32 + 8 * fq;
#pragma unroll
        for (int ai = 0; ai < 2; ++ai)
#pragma unroll
            for (int m = 0; m < 4; ++m) { bf16_t* rowp = base + (size_t)(row0 + ai * HALF + m * 16) * DM + col0;
#pragma unroll
                for (int bj = 0; bj < 2; ++bj) { f32x4 v0 = acc[ai][bj][m][0], v1 = acc[ai][bj][m][1];
                    if (isg) {
#pragma unroll
                        for (int j = 0; j < 4; ++j) { v0[j] = gelu_t(v0[j]); v1[j] = gelu_t(v1[j]); } }
                    u32x4 w; w.x = cvt_pk_bf16(v0[0], v0[1]); w.y = cvt_pk_bf16(v0[2], v0[3]); w.z = cvt_pk_bf16(v1[0], v1[1]); w.w = cvt_pk_bf16(v1[2], v1[3]);
                    *(u32x4*)(rowp + bj * HALF) = w; } }
    }
};
struct EpiLR {
    static constexpr bool PERM = true;
    float* DEC; bf16_t* AB; bf16_t* GB; const float* w0; const float* a0;
    __device__ __forceinline__ void operator()(const f32x4 (&acc)[2][2][4][2], const Unit& u, int wr, int wc, int fr, int fq) const {
        const int type = u.pn >> 2;
        bf16_t* obase = AB; if (type == 2) obase = GB;
        const int row0 = u.pm * BM + wr * 64 + fr, col0 = (u.pn & 3) * BM + wc * 32 + 8 * fq;
#pragma unroll
        for (int bj = 0; bj < 2; ++bj) {
            const int col = col0 + bj * HALF;
            f32x4 c0 = (f32x4){0.f, 0.f, 0.f, 0.f}, c1 = c0;
            if (type == 0) { c0 = *(const f32x4*)(w0 + col); c1 = *(const f32x4*)(w0 + col + 4); }
            else if (type == 1) { c0 = *(const f32x4*)(a0 + col); c1 = *(const f32x4*)(a0 + col + 4); }
#pragma unroll
            for (int ai = 0; ai < 2; ++ai)
#pragma unroll
                for (int m = 0; m < 4; ++m) {
                    const size_t off = (size_t)(row0 + ai * HALF + m * 16) * 1024 + col;
                    f32x4 v0 = acc[ai][bj][m][0] + c0, v1 = acc[ai][bj][m][1] + c1;
                    if (type == 0) {
#pragma unroll
                        for (int j = 0; j < 4; ++j) { v0[j] = __expf(-__expf(-softplus_f(-v0[j]) - 0.5f)); v1[j] = __expf(-__expf(-softplus_f(-v1[j]) - 0.5f)); }
                        *(f32x4*)(DEC + off) = v0; *(f32x4*)(DEC + off + 4) = v1;
                    } else {
                        if (type == 1) {
#pragma unroll
                            for (int j = 0; j < 4; ++j) { v0[j] = sigm(v0[j]); v1[j] = sigm(v1[j]); } }
                        u32x4 w; w.x = cvt_pk_bf16(v0[0], v0[1]); w.y = cvt_pk_bf16(v0[2], v0[3]); w.z = cvt_pk_bf16(v1[0], v1[1]); w.w = cvt_pk_bf16(v1[2], v1[3]);
                        *(u32x4*)(obase + off) = w;
                    }
                }
        }
    }
};
struct EpiGLU {
    static constexpr bool PERM = true;
    const bf16_t* Y5; bf16_t* YCAT;
    __device__ __forceinline__ void operator()(const f32x4 (&acc)[2][2][4][2], const Unit& u, int wr, int wc, int fr, int fq) const {
        const int row0 = u.pm * BM + wr * 64 + fr, col0 = u.pn * BM + wc * 32 + 8 * fq;
#pragma unroll
        for (int ai = 0; ai < 2; ++ai)
#pragma unroll
            for (int m = 0; m < 4; ++m) { const int row = row0 + ai * HALF + m * 16;
#pragma unroll
                for (int bj = 0; bj < 2; ++bj) { const f32x4 v0 = acc[ai][bj][m][0], v1 = acc[ai][bj][m][1];
                    const u32x4 yw = *(const u32x4*)(Y5 + (size_t)row * 1024 + col0 + bj * HALF);
                    float y[8]; unpack8(yw, y);
                    float o[8];
#pragma unroll
                    for (int j = 0; j < 4; ++j) { o[j] = y[j] * sigm(v0[j]); o[4 + j] = y[4 + j] * sigm(v1[j]); }
                    *(u32x4*)(YCAT + (size_t)row * DM + col0 + bj * HALF) = pack8(o); } }
    }
};
struct EpiGates {
    static constexpr bool PERM = true;
    const bf16_t* XC; float* AA; float* BX; const float* b_r; const float* b_i; const float* lam;
    __device__ __forceinline__ void operator()(const f32x4 (&acc)[2][2][4][2], const Unit& u, int wr, int wc, int fr, int fq) const {
        const int row0 = u.pm * BM + wr * 64 + fr, ch0 = (u.pn >> 1) * 256 + (u.pn & 1) * 128 + wc * 32 + 8 * fq;
#pragma unroll
        for (int ai = 0; ai < 2; ++ai)
#pragma unroll
            for (int m = 0; m < 4; ++m) { const int row = row0 + ai * HALF + m * 16; const size_t off = (size_t)row * DM + ch0;
                const u32x4 xw = *(const u32x4*)(XC + off); float xc[8]; unpack8(xw, xc);
#pragma unroll
                for (int n = 0; n < 2; ++n) {
                    const f32x4 br = *(const f32x4*)(b_r + ch0 + 4 * n), bi = *(const f32x4*)(b_i + ch0 + 4 * n), lm = *(const f32x4*)(lam + ch0 + 4 * n);
                    f32x4 av, bv;
#pragma unroll
                    for (int j = 0; j < 4; ++j) {
                        const float gr = acc[ai][0][m][n][j] + br[j], gi = acc[ai][1][m][n][j] + bi[j];
                        const float la = -8.0f * sigm(gr) * softplus_f(-lm[j]);
                        const float a = __expf(la);
                        const float mult = sqrtf(fmaxf(1.0f - __expf(2.0f * la), 0.f));
                        av[j] = a; bv[j] = mult * sigm(gi) * xc[4 * n + j];
                    }
                    *(f32x4*)(AA + off + 4 * n) = av; *(f32x4*)(BX + off + 4 * n) = bv;
                } }
    }
};
struct EpiGU {
    static constexpr bool PERM = true;
    bf16_t* ACT;
    __device__ __forceinline__ void operator()(const f32x4 (&acc)[2][2][4][2], const Unit& u, int wr, int wc, int fr, int fq) const {
        const int row0 = u.pm * BM + wr * 64 + fr, col0 = u.pn * HALF + wc * 32 + 8 * fq;
#pragma unroll
        for (int ai = 0; ai < 2; ++ai)
#pragma unroll
            for (int m = 0; m < 4; ++m) { const int row = row0 + ai * HALF + m * 16;
                float o[8];
#pragma unroll
                for (int n = 0; n < 2; ++n)
#pragma unroll
                    for (int j = 0; j < 4; ++j) { const float g = acc[ai][0][m][n][j]; o[4 * n + j] = g * sigm(g) * acc[ai][1][m][n][j]; }
                *(u32x4*)(ACT + (size_t)row * DFF + col0) = pack8(o); }
    }
};

template <class Epi>
__device__ __forceinline__ void gemm_phase(LAS unsigned char* lds, const Gemm g, const StaticOrder& S, const Epi& E, int tid  ) {
    const int wid = __builtin_amdgcn_readfirstlane(tid >> 6), lane = tid & 63, wr = wid >> 2, wc = wid & 3, fr = lane & 15, fq = lane >> 4;
    const int K = g.K, nt = K / BK;
    unsigned voffA[2], voffB[2];
#pragma unroll
    for (int i = 0; i < 2; ++i) { int R, C; stage_rc(tid * 16 + i * 8192, R, C); const int Rb = Epi::PERM ? ((R & ~31) + perm32(R & 31)) : R;
        voffA[i] = (unsigned)(R * g.lda + C) * 2u; voffB[i] = (unsigned)(Rb * K + C) * 2u; }
    const size_t kstep = (size_t)(BK * 2);
    const size_t hstepA = (size_t)HALF * g.lda * 2, hstepB = (size_t)HALF * K * 2;
    const size_t tstepA = 2 * hstepA, tstepB = 2 * hstepB;
    const unsigned ldsw = (unsigned)wid * 1024u;
    const int aoff = lds_byte(wr * 64 + fr, fq * 8), boff = lds_byte(wc * 32 + fr, fq * 8);
#define PG8_SA(b, h) (((b) * 2 + (h)) * HTB)
#define PG8_SB(b, h) ((4 + (b) * 2 + (h)) * HTB)
#define PG8_STAGE(bufoff, gbase, voff) do { _Pragma("unroll") for (int _i = 0; _i < 2; ++_i) \
        __builtin_amdgcn_global_load_lds((const unsigned*)((const char*)(gbase) + (voff)[_i]), (LAS unsigned*)(lds + (bufoff) + ldsw + _i * 8192), 16, 0, 0); } while (0)
#define PG8_LDA(dst, b, h) do { _Pragma("unroll") for (int m = 0; m < 4; ++m) _Pragma("unroll") for (int k = 0; k < 2; ++k) dst[m][k] = *(const LAS bf16x8*)(lds + PG8_SA(b, h) + aoff + m * 2048 + k * 1024); } while (0)
#define PG8_LDB(dst, b, h) do { _Pragma("unroll") for (int n = 0; n < 2; ++n) _Pragma("unroll") for (int k = 0; k < 2; ++k) dst[n][k] = *(const LAS bf16x8*)(lds + PG8_SB(b, h) + boff + n * 2048 + k * 1024); } while (0)
#define PG8_MMA(ai, bj, At, Bt) do { __builtin_amdgcn_s_setprio(1); _Pragma("unroll") for (int m = 0; m < 4; ++m) _Pragma("unroll") for (int n = 0; n < 2; ++n) _Pragma("unroll") for (int k = 0; k < 2; ++k) \
        acc[ai][bj][m][n] = __builtin_amdgcn_mfma_f32_16x16x32_bf16(Bt[n][k], At[m][k], acc[ai][bj][m][n], 0, 0, 0); __builtin_amdgcn_s_setprio(0); } while (0)
#define PG8_WAIT_V(n) asm volatile("s_waitcnt vmcnt(" #n ")" ::: "memory")
#define PG8_WAIT_L(n) asm volatile("s_waitcnt lgkmcnt(" #n ")" ::: "memory")
#define PG8_BAR __builtin_amdgcn_s_barrier()
#define PG8_SCHED __builtin_amdgcn_sched_barrier(0)
#define PG8_AOF(u) ((const char*)g.A + (size_t)(u).pm * tstepA + (size_t)(((u).pn >> g.apn_shift) * g.apn_mul) * 2)
#define PG8_BOF(u) ((const char*)g.Bt + (size_t)(u).pn * tstepB)
    Unit cur, nxt; int ui = 0;
    if (!S.next(0, cur)) return;
    f32x4 acc[2][2][4][2];
#pragma unroll
    for (int a = 0; a < 2; ++a)
#pragma unroll
        for (int b = 0; b < 2; ++b)
#pragma unroll
            for (int m = 0; m < 4; ++m)
#pragma unroll
                for (int n = 0; n < 2; ++n) acc[a][b][m][n] = (f32x4){0.f, 0.f, 0.f, 0.f};
    bf16x8 At[4][2], B0[2][2], B1[2][2];
    const char* cA = PG8_AOF(cur); const char* cB = PG8_BOF(cur);
    PG8_STAGE(PG8_SB(0, 0), cB, voffB); PG8_STAGE(PG8_SA(0, 0), cA, voffA); PG8_STAGE(PG8_SB(0, 1), cB + hstepB, voffB); PG8_STAGE(PG8_SA(0, 1), cA + hstepA, voffA);
    if (wr == 1) PG8_BAR;
    PG8_WAIT_V(4); PG8_BAR;
    PG8_STAGE(PG8_SB(1, 0), cB + kstep, voffB); PG8_STAGE(PG8_SA(1, 0), cA + kstep, voffA); PG8_STAGE(PG8_SB(1, 1), cB + hstepB + kstep, voffB);
    PG8_WAIT_V(6); PG8_BAR;
    for (;;) {
        const bool has_next = S.next(ui + 1, nxt);
        const char* nA = has_next ? PG8_AOF(nxt) : cA; const char* nB = has_next ? PG8_BOF(nxt) : cB;
        for (int t = 0; t < nt; t += 2) {
            const bool last = (t == nt - 2);
            const char* a1 = cA + (size_t)(t + 1) * kstep;
            const char* a2 = last ? nA : cA + (size_t)(t + 2) * kstep; const char* b2 = last ? nB : cB + (size_t)(t + 2) * kstep;
            const char* a3 = a2 + kstep; const char* b3 = b2 + kstep;
            PG8_LDB(B0, 0, 0); PG8_SCHED; PG8_LDA(At, 0, 0); PG8_STAGE(PG8_SA(1, 1), a1 + hstepA, voffA);
            PG8_WAIT_L(8); PG8_BAR; PG8_WAIT_L(0); PG8_MMA(0, 0, At, B0); PG8_BAR; PG8_SCHED;
            PG8_LDB(B1, 0, 1); PG8_STAGE(PG8_SB(0, 0), b2, voffB);
            PG8_BAR; PG8_WAIT_L(0); PG8_MMA(0, 1, At, B1); PG8_BAR;
            PG8_LDA(At, 0, 1); PG8_STAGE(PG8_SA(0, 0), a2, voffA);
            PG8_BAR; PG8_WAIT_L(0); PG8_MMA(1, 0, At, B0); PG8_BAR; PG8_SCHED;
            PG8_STAGE(PG8_SB(0, 1), b2 + hstepB, voffB);
            PG8_WAIT_V(6); PG8_BAR; PG8_MMA(1, 1, At, B1); PG8_BAR;
            PG8_LDB(B0, 1, 0); PG8_SCHED; PG8_LDA(At, 1, 0); PG8_STAGE(PG8_SA(0, 1), a2 + hstepA, voffA);
            PG8_WAIT_L(8); PG8_BAR; PG8_WAIT_L(0); PG8_MMA(0, 0, At, B0); PG8_BAR; PG8_SCHED;
            PG8_LDB(B1, 1, 1); PG8_STAGE(PG8_SB(1, 0), b3, voffB);
            PG8_BAR; PG8_WAIT_L(0); PG8_MMA(0, 1, At, B1); PG8_BAR;
            PG8_LDA(At, 1, 1); PG8_STAGE(PG8_SA(1, 0), a3, voffA);
            PG8_BAR; PG8_WAIT_L(0); PG8_MMA(1, 0, At, B0); PG8_BAR; PG8_SCHED;
            PG8_STAGE(PG8_SB(1, 1), b3 + hstepB, voffB);
            PG8_WAIT_V(6); PG8_BAR; PG8_MMA(1, 1, At, B1); PG8_BAR;
        }
        E(acc, cur, wr, wc, fr, fq);
        if (!has_next) break;
#pragma unroll
        for (int a = 0; a < 2; ++a)
#pragma unroll
            for (int b = 0; b < 2; ++b)
#pragma unroll
                for (int m = 0; m < 4; ++m)
#pragma unroll
                    for (int n = 0; n < 2; ++n) acc[a][b][m][n] = (f32x4){0.f, 0.f, 0.f, 0.f};
        cur = nxt; cA = nA; cB = nB; ++ui;
    }
    PG8_WAIT_V(0);
    if (wr == 0) PG8_BAR;
    PG8_BAR;
#undef PG8_SA
#undef PG8_SB
#undef PG8_STAGE
#undef PG8_LDA
#undef PG8_LDB
#undef PG8_MMA
#undef PG8_WAIT_V
#undef PG8_WAIT_L
#undef PG8_BAR
#undef PG8_SCHED
#undef PG8_AOF
#undef PG8_BOF
}

__device__ __forceinline__ void tr_item(const float* W, int ldw, int k0, int n0, bf16_t* WT, int ldt, int drow0, int dk0, LAS float* scr, int lane) {
#pragma unroll 8
    for (int i = 0; i < 32; ++i) { const int kk = 2 * i + (lane >> 5); scr[kk * 33 + (lane & 31)] = W[(size_t)(k0 + kk) * ldw + n0 + (lane & 31)]; }
    LDS_WAIT(); asm volatile("" ::: "memory");
    const int c = lane & 7;
#pragma unroll
    for (int j = 0; j < 4; ++j) { const int n = (lane >> 3) + 8 * j; const LAS float* s = scr + (8 * c) * 33 + n;
        u32x4 o; o.x = cvt_pk_bf16(s[0 * 33], s[1 * 33]); o.y = cvt_pk_bf16(s[2 * 33], s[3 * 33]); o.z = cvt_pk_bf16(s[4 * 33], s[5 * 33]); o.w = cvt_pk_bf16(s[6 * 33], s[7 * 33]);
        *(u32x4*)(WT + (size_t)(drow0 + n) * ldt + dk0 + 8 * c) = o; }
    LDS_WAIT(); asm volatile("" ::: "memory");
}
#define TR_JOB(W, ldw, K, N, WT, ldt, DROW) do { const int nblk_ = (N) / 32, nit_ = ((K) / 64) * nblk_; \
    for (int it_ = gw; it_ < nit_; it_ += NGW) { const int kb_ = it_ / nblk_, nl = (it_ % nblk_) * 32; tr_item((W), (ldw), kb_ * 64, nl, (WT), (ldt), (DROW), kb_ * 64, scr, lane); } } while (0)

__device__ __forceinline__ void norm_rows(const float* Y, const float* Xin, float* Xout, const float* gpost, const float* gnext, bf16_t* H, int gw, int NGW, int lane) {
    for (int row = gw; row < MTOK; row += NGW) {
        const f32x4* xr = (const f32x4*)(Xin + (size_t)row * DM) + lane;
        f32x4 x[8];
#pragma unroll
        for (int j = 0; j < 8; ++j) x[j] = xr[64 * j];
        if (Y) {
            const f32x4* yr = (const f32x4*)(Y + (size_t)row * DM) + lane;
            f32x4 y[8]; float s = 0.f;
#pragma unroll
            for (int j = 0; j < 8; ++j) { y[j] = yr[64 * j]; s += (y[j][0] * y[j][0] + y[j][1] * y[j][1]) + (y[j][2] * y[j][2] + y[j][3] * y[j][3]); }
            const float rinv = rsqrtf(wave_sum(s) * (1.0f / DM) + 1e-6f);
#pragma unroll
            for (int j = 0; j < 8; ++j) { const f32x4 gp = *((const f32x4*)gpost + lane + 64 * j); x[j] = x[j] + y[j] * rinv * gp; }
        }
        if (Xout) { f32x4* xo = (f32x4*)(Xout + (size_t)row * DM) + lane;
#pragma unroll
            for (int j = 0; j < 8; ++j) xo[64 * j] = x[j]; }
        if (gnext) {
            float s = 0.f;
#pragma unroll
            for (int j = 0; j < 8; ++j) s += (x[j][0] * x[j][0] + x[j][1] * x[j][1]) + (x[j][2] * x[j][2] + x[j][3] * x[j][3]);
            const float rinv = rsqrtf(wave_sum(s) * (1.0f / DM) + 1e-6f);
            u32x2* ho = (u32x2*)(H + (size_t)row * DM) + lane;
#pragma unroll
            for (int j = 0; j < 8; ++j) { const f32x4 gn = *((const f32x4*)gnext + lane + 64 * j); const f32x4 v = x[j] * rinv * gn;
                u32x2 w; w.x = cvt_pk_bf16(v[0], v[1]); w.y = cvt_pk_bf16(v[2], v[3]); ho[64 * j] = w; }
        }
    }
}

typedef float f32x2 __attribute__((ext_vector_type(2)));
__device__ __forceinline__ void rwkv_scan(LAS unsigned char* ldsb, int wi, const bf16_t* P, const float* DEC, const bf16_t* AB, float* YRAW,
                                          const float* mu, const float* k_k, const float* k_a, int tid) {
    const int lane = tid & 63, wid = __builtin_amdgcn_readfirstlane(tid >> 6);
    const int b = wi >> 6, h = (wi >> 2) & 15, qr = wi & 3;
    constexpr int CH = 32, NCH = TSEQ / CH, ARR = CH * 64, BUF = 5 * ARR + 2 * CH * 16;
    LAS float* L = (LAS float*)ldsb;
    const int ptid = tid - 256, pt = (ptid >> 3) & 31, pc = (ptid & 7) * 8;
    const int hc = h * 64 + pc;
    const size_t mbase = (size_t)b * TSEQ;
    float mur[8], muk[8], muv[8], kkc[8], kac[8];
    u32x4 rc, rp, kc, kp, vc, vp, aw; f32x4 d0, d1;
    const u32x4 z4 = (u32x4){0u, 0u, 0u, 0u};
#define RW_LOAD(ch) do { const size_t m_ = mbase + (size_t)(ch) * CH + pt; const bf16_t* pr_ = P + m_ * EVIN_NP + 1024 + hc; const bool hp_ = ((ch) * CH + pt) > 0; \
        rc = *(const u32x4*)(pr_); kc = *(const u32x4*)(pr_ + 1024); vc = *(const u32x4*)(pr_ + 2048); \
        rp = hp_ ? *(const u32x4*)(pr_ - EVIN_NP) : z4; kp = hp_ ? *(const u32x4*)(pr_ - EVIN_NP + 1024) : z4; vp = hp_ ? *(const u32x4*)(pr_ - EVIN_NP + 2048) : z4; \
        aw = *(const u32x4*)(AB + m_ * 1024 + hc); d0 = *(const f32x4*)(DEC + m_ * 1024 + hc); d1 = *(const f32x4*)(DEC + m_ * 1024 + hc + 4); } while (0)
#define RW_PREP(B_) do { LAS float* bb_ = (B_); float r[8], k[8], v[8], a[8], t8[8]; \
        unpack8(rc, r); unpack8(rp, t8); _Pragma("unroll") for (int j = 0; j < 8; ++j) r[j] = r[j] + (t8[j] - r[j]) * mur[j]; \
        unpack8(kc, k); unpack8(kp, t8); _Pragma("unroll") for (int j = 0; j < 8; ++j) k[j] = k[j] + (t8[j] - k[j]) * muk[j]; \
        unpack8(vc, v); unpack8(vp, t8); _Pragma("unroll") for (int j = 0; j < 8; ++j) v[j] = v[j] + (t8[j] - v[j]) * muv[j]; \
        unpack8(aw, a); float kk[8]; float ss = 0.f; \
        _Pragma("unroll") for (int j = 0; j < 8; ++j) { kk[j] = k[j] * kkc[j]; ss += kk[j] * kk[j]; } \
        ss += __shfl_xor(ss, 1); ss += __shfl_xor(ss, 2); ss += __shfl_xor(ss, 4); \
        const float rn = rsqrtf(fmaxf(ss, 1e-24f)); f32x4 o0, o1; LAS float* dst; \
        dst = bb_ + pt * 64 + pc; o0 = (f32x4){r[0], r[1], r[2], r[3]}; o1 = (f32x4){r[4], r[5], r[6], r[7]}; *(LAS f32x4*)dst = o0; *(LAS f32x4*)(dst + 4) = o1; \
        dst = bb_ + ARR + pt * 64 + pc; *(LAS f32x4*)dst = d0; *(LAS f32x4*)(dst + 4) = d1; \
        _Pragma("unroll") for (int j = 0; j < 4; ++j) { o0[j] = k[j] * (1.0f + (a[j] - 1.0f) * kac[j]); o1[j] = k[4 + j] * (1.0f + (a[4 + j] - 1.0f) * kac[4 + j]); } \
        dst = bb_ + 2 * ARR + pt * 64 + pc; *(LAS f32x4*)dst = o0; *(LAS f32x4*)(dst + 4) = o1; \
        _Pragma("unroll") for (int j = 0; j < 4; ++j) { o0[j] = -kk[j] * rn; o1[j] = -kk[4 + j] * rn; } \
        dst = bb_ + 3 * ARR + pt * 64 + pc; *(LAS f32x4*)dst = o0; *(LAS f32x4*)(dst + 4) = o1; \
        _Pragma("unroll") for (int j = 0; j < 4; ++j) { o0[j] = kk[j] * rn * a[j]; o1[j] = kk[4 + j] * rn * a[4 + j]; } \
        dst = bb_ + 4 * ARR + pt * 64 + pc; *(LAS f32x4*)dst = o0; *(LAS f32x4*)(dst + 4) = o1; \
        if ((pc >> 4) == qr) { dst = bb_ + 5 * ARR + pt * 16 + (pc & 15); o0 = (f32x4){v[0], v[1], v[2], v[3]}; o1 = (f32x4){v[4], v[5], v[6], v[7]}; *(LAS f32x4*)dst = o0; *(LAS f32x4*)(dst + 4) = o1; } } while (0)
#define RW_WOUT(ch) do { if (ptid < 128) { const int t_ = ptid >> 2, j4_ = (ptid & 3) * 4; const f32x4 yv_ = *(const LAS f32x4*)(L + ((ch) & 1) * BUF + 5 * ARR + CH * 16 + t_ * 16 + j4_); \
        *(f32x4*)(YRAW + (mbase + (size_t)(ch) * CH + t_) * 1024 + h * 64 + qr * 16 + j4_) = yv_; } } while (0)
    if (wid >= 4) {
#pragma unroll
        for (int j = 0; j < 8; ++j) { mur[j] = mu[hc + j]; muk[j] = mu[1024 + hc + j]; muv[j] = mu[2048 + hc + j]; kkc[j] = k_k[hc + j]; kac[j] = k_a[hc + j]; }
        RW_LOAD(0); RW_PREP(L); RW_LOAD(1);
    }
    __syncthreads();
    const int rowl = (wid & 3) * 4 + (lane >> 4), kq = (lane & 15) * 4;
    f32x2 s01 = (f32x2){0.f, 0.f}, s23 = (f32x2){0.f, 0.f};
    for (int c = 0; c < NCH; ++c) {
        if (wid < 4) {
            const LAS float* cb = L + (c & 1) * BUF + kq;
            const LAS float* vb = L + (c & 1) * BUF + 5 * ARR + rowl;
            LAS float* yb = L + (c & 1) * BUF + 5 * ARR + CH * 16 + rowl;
            const int lj = lane & 15;
            for (int t16 = 0; t16 < CH; t16 += 16) {
                float ykeep = 0.f;
#pragma unroll
                for (int tt = 0; tt < 16; ++tt) {
                    const int t = t16 + tt;
                    const f32x4 r4 = *(const LAS f32x4*)(cb + t * 64), w4 = *(const LAS f32x4*)(cb + ARR + t * 64), k4 = *(const LAS f32x4*)(cb + 2 * ARR + t * 64);
                    const f32x4 a4 = *(const LAS f32x4*)(cb + 3 * ARR + t * 64), b4 = *(const LAS f32x4*)(cb + 4 * ARR + t * 64);
                    const float vv = vb[t * 16];
                    const f32x2 vv2 = (f32x2){vv, vv};
                    const f32x2 pa = s01 * (f32x2){a4[0], a4[1]} + s23 * (f32x2){a4[2], a4[3]};
                    const f32x2 t01 = s01 * (f32x2){w4[0], w4[1]} + vv2 * (f32x2){k4[0], k4[1]};
                    const f32x2 t23 = s23 * (f32x2){w4[2], w4[3]} + vv2 * (f32x2){k4[2], k4[3]};
                    const float sa = row16_sum(pa[0] + pa[1]);
                    const f32x2 sa2 = (f32x2){sa, sa};
                    s01 = sa2 * (f32x2){b4[0], b4[1]} + t01;
                    s23 = sa2 * (f32x2){b4[2], b4[3]} + t23;
                    const f32x2 py = s01 * (f32x2){r4[0], r4[1]} + s23 * (f32x2){r4[2], r4[3]};
                    const float y = row16_sum(py[0] + py[1]);
                    ykeep = (lj == tt) ? y : ykeep;
                }
                yb[(t16 + lj) * 16] = ykeep;
            }
        } else {
            if (c + 1 < NCH) { RW_PREP(L + ((c + 1) & 1) * BUF); if (c + 2 < NCH) RW_LOAD(c + 2); }
            if (c > 0) RW_WOUT(c - 1);
        }
        __syncthreads();
    }
    if (wid >= 4) RW_WOUT(NCH - 1);
#undef RW_LOAD
#undef RW_PREP
#undef RW_WOUT
}

__device__ __forceinline__ void rwkv_post(int gt, int NGT, const float* YRAW, const bf16_t* P, const bf16_t* AB, const bf16_t* GB, bf16_t* YCAT,
                                          const float* mu, const float* k_a, const float* r_k, const float* lnw, const float* lnb) {
    for (int it = gt; it < MTOK * 128; it += NGT) {
        const int m = it >> 7, hc = (it & 127) * 8;
        const bf16_t* pr = P + (size_t)m * EVIN_NP + 1024 + hc; const bool hp = (m & (TSEQ - 1)) != 0;
        const u32x4 z4 = (u32x4){0u, 0u, 0u, 0u};
        const u32x4 rc = *(const u32x4*)pr, kc = *(const u32x4*)(pr + 1024), vc = *(const u32x4*)(pr + 2048);
        const u32x4 rp = hp ? *(const u32x4*)(pr - EVIN_NP) : z4, kp = hp ? *(const u32x4*)(pr - EVIN_NP + 1024) : z4, vp = hp ? *(const u32x4*)(pr - EVIN_NP + 2048) : z4;
        const u32x4 aw = *(const u32x4*)(AB + (size_t)m * 1024 + hc), gw_ = *(const u32x4*)(GB + (size_t)m * 1024 + hc);
        const f32x4 y0 = *(const f32x4*)(YRAW + (size_t)m * 1024 + hc), y1 = *(const f32x4*)(YRAW + (size_t)m * 1024 + hc + 4);
        float r[8], k[8], v[8], a[8], gg[8], t8[8], y[8];
        unpack8(rc, r); unpack8(rp, t8);
#pragma unroll
        for (int j = 0; j < 8; ++j) r[j] = r[j] + (t8[j] - r[j]) * mu[hc + j];
        unpack8(kc, k); unpack8(kp, t8);
#pragma unroll
        for (int j = 0; j < 8; ++j) k[j] = k[j] + (t8[j] - k[j]) * mu[1024 + hc + j];
        unpack8(vc, v); unpack8(vp, t8);
#pragma unroll
        for (int j = 0; j < 8; ++j) v[j] = v[j] + (t8[j] - v[j]) * mu[2048 + hc + j];
        unpack8(aw, a); unpack8(gw_, gg);
#pragma unroll
        for (int j = 0; j < 4; ++j) { y[j] = y0[j]; y[4 + j] = y1[j]; }
        float s = 0.f, bo = 0.f;
#pragma unroll
        for (int j = 0; j < 8; ++j) { s += y[j]; const float kx = k[j] * (1.0f + (a[j] - 1.0f) * k_a[hc + j]); bo += r[j] * kx * r_k[hc + j]; }
        s += __shfl_xor(s, 1); s += __shfl_xor(s, 2); s += __shfl_xor(s, 4);
        bo += __shfl_xor(bo, 1); bo += __shfl_xor(bo, 2); bo += __shfl_xor(bo, 4);
        const float mean = s * (1.0f / 64.0f);
        float q = 0.f;
#pragma unroll
        for (int j = 0; j < 8; ++j) { y[j] -= mean; q += y[j] * y[j]; }
        q += __shfl_xor(q, 1); q += __shfl_xor(q, 2); q += __shfl_xor(q, 4);
        const float rstd = rsqrtf(q * (1.0f / 64.0f) + 64e-5f);
        float o[8];
#pragma unroll
        for (int j = 0; j < 8; ++j) o[j] = (y[j] * rstd * lnw[hc + j] + lnb[hc + j] + bo * v[j]) * gg[j];
        *(u32x4*)(YCAT + (size_t)m * DM + 1024 + hc) = pack8(o);
    }
}

__device__ __forceinline__ void s5_scan(LAS unsigned char* ldsb, int pair, const bf16_t* P, bf16_t* Y5, const float* lam_re, const float* lam_im, const float* log_dt,
                                        const float* b_re, const float* b_im, const float* c_re, const float* c_im, const float* dsk, int tid) {
    const int lane = tid & 63, wid = __builtin_amdgcn_readfirstlane(tid >> 6), fr = lane & 15, fq = lane >> 4;
    const int b = pair >> 6, g = pair & 63;
    LAS float* BR = (LAS float*)ldsb;
    LAS float* BI = BR + 64 * 68;
    LAS bf16_t* SR = (LAS bf16_t*)(BI + 64 * 68);
    LAS bf16_t* SI = SR + 64 * 72;
    const float dt = __expf(log_dt[g]);
    const int tt = wid & 3, ri = wid >> 2;
    bf16x8 bfrag[4];
#pragma unroll
    for (int pt = 0; pt < 4; ++pt) {
        const int p = pt * 16 + fr;
        const float lr = lam_re[g * 64 + p], li = lam_im[g * 64 + p];
        const float mag = __expf(lr * dt), ang = li * dt;
        const float are = mag * cosf(ang), aim = mag * sinf(ang);
        const float den = lr * lr + li * li, nr = are - 1.0f, ni = aim;
        const float gre = (nr * lr + ni * li) / den, gim = (ni * lr - nr * li) / den;
        float o[8];
#pragma unroll
        for (int e = 0; e < 8; ++e) {
            float val = 0.f;
            if (fq < 2) { const float br = b_re[(size_t)(g * 64 + p) * 16 + fq * 8 + e], bi = b_im[(size_t)(g * 64 + p) * 16 + fq * 8 + e];
                val = ri ? (gre * bi + gim * br) : (gre * br - gim * bi); }
            o[e] = val;
        }
        const u32x4 w = pack8(o); bfrag[pt] = __builtin_bit_cast(bf16x8, w);
    }
    float are_, aim_;
    { const float lr = lam_re[g * 64 + lane], li = lam_im[g * 64 + lane]; const float mag = __expf(lr * dt), ang = li * dt; are_ = mag * cosf(ang); aim_ = mag * sinf(ang); }
    bf16x8 cfrag[4];
#pragma unroll
    for (int kk = 0; kk < 4; ++kk) {
        float o[8];
#pragma unroll
        for (int e = 0; e < 8; ++e) { const int p = (kk & 1) * 32 + fq * 8 + e; o[e] = (kk < 2) ? c_re[(size_t)(g * 16 + fr) * 64 + p] : -c_im[(size_t)(g * 16 + fr) * 64 + p]; }
        const u32x4 w = pack8(o); cfrag[kk] = __builtin_bit_cast(bf16x8, w);
    }
    const f32x4 d4 = *(const f32x4*)(dsk + g * 16 + fq * 4);
    float sre = 0.f, sim = 0.f;
    const size_t m0 = (size_t)b * TSEQ;
    const u32x4 z4 = (u32x4){0u, 0u, 0u, 0u};
    u32x4 ucur = (fq < 2) ? *(const u32x4*)(P + (m0 + tt * 16 + fr) * EVIN_NP + g * 16 + fq * 8) : z4;
    for (int ch = 0; ch < TSEQ / 64; ++ch) {
        const size_t mc = m0 + (size_t)ch * 64;
        u32x4 unext = z4;
        if (ch + 1 < TSEQ / 64 && fq < 2) unext = *(const u32x4*)(P + (mc + 64 + tt * 16 + fr) * EVIN_NP + g * 16 + fq * 8);
        u32x2 usk = (u32x2){0u, 0u};
        if (wid < 4) usk = *(const u32x2*)(P + (mc + wid * 16 + fr) * EVIN_NP + g * 16 + fq * 4);
        {
            const bf16x8 ufrag = __builtin_bit_cast(bf16x8, ucur);
            LAS float* dst = (ri ? BI : BR) + (tt * 16 + fq * 4) * 68 + fr;
#pragma unroll
            for (int pt = 0; pt < 4; ++pt) {
                f32x4 d = (f32x4){0.f, 0.f, 0.f, 0.f};
                d = __builtin_amdgcn_mfma_f32_16x16x32_bf16(ufrag, bfrag[pt], d, 0, 0, 0);
#pragma unroll
                for (int jj = 0; jj < 4; ++jj) dst[jj * 68 + pt * 16] = d[jj];
            }
        }
        __syncthreads();
        if (wid == 0) {
#pragma unroll
            for (int t8 = 0; t8 < 8; ++t8) {
                float xr[8], xi[8];
#pragma unroll
                for (int i = 0; i < 8; ++i) { xr[i] = BR[(t8 * 8 + i) * 68 + lane]; xi[i] = BI[(t8 * 8 + i) * 68 + lane]; }
#pragma unroll
                for (int i = 0; i < 8; ++i) {
                    const float nre = are_ * sre - aim_ * sim + xr[i], nim = are_ * sim + aim_ * sre + xi[i];
                    sre = nre; sim = nim;
                    const unsigned w = cvt_pk_bf16(sre, sim);
                    SR[(t8 * 8 + i) * 72 + lane] = (bf16_t)(w & 0xffffu); SI[(t8 * 8 + i) * 72 + lane] = (bf16_t)(w >> 16);
                }
            }
        }
        __syncthreads();
        if (wid < 4) {
            f32x4 d = (f32x4){0.f, 0.f, 0.f, 0.f};
#pragma unroll
            for (int kk = 0; kk < 4; ++kk) {
                const LAS bf16_t* src = ((kk < 2) ? SR : SI) + (wid * 16 + fr) * 72 + (kk & 1) * 32 + fq * 8;
                const bf16x8 sfrag = *(const LAS bf16x8*)src;
                d = __builtin_amdgcn_mfma_f32_16x16x32_bf16(cfrag[kk], sfrag, d, 0, 0, 0);
            }
            const float u0 = bflo(usk.x), u1 = bfhi(usk.x), u2 = bflo(usk.y), u3 = bfhi(usk.y);
            const float y0 = gelu_t(d[0] + d4[0] * u0), y1 = gelu_t(d[1] + d4[1] * u1), y2 = gelu_t(d[2] + d4[2] * u2), y3 = gelu_t(d[3] + d4[3] * u3);
            u32x2 w; w.x = cvt_pk_bf16(y0, y1); w.y = cvt_pk_bf16(y2, y3);
            *(u32x2*)(Y5 + (mc + wid * 16 + fr) * 1024 + g * 16 + fq * 4) = w;
        }
        ucur = unext;
    }
}

__device__ __forceinline__ void lru_scan(LAS unsigned char* ldsb, int wi, const float* AA, const float* BX, const bf16_t* GATE, bf16_t* HG, int tid) {
    const int c = tid & 31, seg = tid >> 5;
    const int b = wi >> 6, ch = (wi & 63) * 32 + c;
    LAS float* SA = (LAS float*)ldsb; LAS float* SH = SA + 512;
    const size_t base = ((size_t)b * TSEQ + (size_t)seg * 256) * DM + ch;
    float Ap = 1.f, h = 0.f;
#pragma unroll 8
    for (int t = 0; t < 256; ++t) { const float a = AA[base + (size_t)t * DM], x = BX[base + (size_t)t * DM]; h = a * h + x; Ap *= a; }
    SA[seg * 32 + c] = Ap; SH[seg * 32 + c] = h;
    __syncthreads();
    float hin = 0.f;
    for (int s = 0; s < seg; ++s) hin = SA[s * 32 + c] * hin + SH[s * 32 + c];
    h = hin;
#pragma unroll 8
    for (int t = 0; t < 256; ++t) { const float a = AA[base + (size_t)t * DM], x = BX[base + (size_t)t * DM]; h = a * h + x;
        const float gt = __uint_as_float((unsigned)GATE[base + (size_t)t * DM] << 16);
        HG[base + (size_t)t * DM] = (bf16_t)(cvt_pk_bf16(h * gt, 0.f) & 0xffffu); }
    __syncthreads();
}

#define XB_TMO      128
#define XB_XCNT(j)  (256  + 64 * (j))
#define XB_XSUB(j)  (1280 + 64 * (j))
#define XB_XGEN(j)  (2304 + 64 * (j))
#define XB_TOP      3328
#define XB_TOPGEN   3392
#define XCD_BAR_WORDS 3456
#define XB_SPIN_CAP (1u << 18)
__device__ __forceinline__ unsigned xb_ld(unsigned* p)              { return __hip_atomic_load(p, __ATOMIC_RELAXED, __HIP_MEMORY_SCOPE_AGENT); }
__device__ __forceinline__ unsigned xb_add(unsigned* p, unsigned v) { return __hip_atomic_fetch_add(p, v, __ATOMIC_RELAXED, __HIP_MEMORY_SCOPE_AGENT); }
__device__ __forceinline__ unsigned xb_xcc_id() { return (unsigned)__builtin_amdgcn_s_getreg((3 << 11) | 20) & 0xFu; }
#define XB_SPIN(cond, bar) do { unsigned _sp = 0; while (cond) { __builtin_amdgcn_s_sleep(1); \
    if ((++_sp & 255u) == 0u) { if (xb_ld(&(bar)[XB_TMO])) break; if (_sp > XB_SPIN_CAP) { atomicAdd(&(bar)[XB_TMO], 1u); break; } } } } while (0)
struct XcdBarrier { unsigned* bar; unsigned x; volatile LAS unsigned* st; };
__device__ __forceinline__ void xcd_barrier_complete(unsigned* bar, unsigned x, unsigned& nloc, unsigned& nx) {
    const unsigned G = gridDim.x * gridDim.y * gridDim.z;
    unsigned sum, cnt, mine, sp = 0u;
    for (;;) {
        sum = 0u; cnt = 0u; mine = 0u;
#pragma unroll
        for (unsigned j = 0; j < 16; ++j) { const unsigned c = xb_ld(&bar[XB_XCNT(j)]); sum += c; cnt += (c > 0u) ? 1u : 0u; mine = (j == x) ? c : mine; }
        if (sum == G) break;
        __builtin_amdgcn_s_sleep(1);
        if ((++sp & 255u) == 0u) { if (xb_ld(&bar[XB_TMO])) break; if (sp > XB_SPIN_CAP) { atomicAdd(&bar[XB_TMO], 1u); break; } }
    }
    nloc = mine > 0u ? mine : 1u; nx = cnt > 0u ? cnt : 1u;
}
__device__ __forceinline__ void xcd_barrier(const XcdBarrier& b, int tid_) {
    asm volatile("s_waitcnt vmcnt(0)" ::: "memory");
    __syncthreads();
    if (tid_ == 0) {
        unsigned* bar = b.bar;
        __builtin_amdgcn_s_waitcnt(0);
        unsigned nloc = b.st[0], nx = b.st[1];
        if (nloc == 0u) { xcd_barrier_complete(bar, b.x, nloc, nx); b.st[0] = nloc; b.st[1] = nx; }
        const unsigned old = xb_add(&bar[XB_XSUB(b.x)], 1u);
        const unsigned gen = old / nloc;
        if (old + 1u == (gen + 1u) * nloc) {
            __builtin_amdgcn_fence(__ATOMIC_RELEASE, "agent");
            asm volatile("s_waitcnt vmcnt(0)" ::: "memory");
            const unsigned og = xb_add(&bar[XB_TOP], 1u);
            const unsigned tg = og / nx;
            if (og + 1u == (tg + 1u) * nx) xb_add(&bar[XB_TOPGEN], 1u);
            else XB_SPIN(xb_ld(&bar[XB_TOPGEN]) == tg, bar);
            __builtin_amdgcn_fence(__ATOMIC_ACQUIRE, "agent");
            xb_add(&bar[XB_XGEN(b.x)], 1u);
            asm volatile("s_waitcnt vmcnt(0)" ::: "memory");
        } else {
            XB_SPIN(xb_ld(&bar[XB_XGEN(b.x)]) == gen, bar);
            __builtin_amdgcn_fence(__ATOMIC_ACQUIRE, "agent");
            asm volatile("s_waitcnt vmcnt(0)" ::: "memory");
        }
    }
    __syncthreads();
}

typedef __attribute__((address_space(4))) const Params CParams;
#define KP() ({ CParams* q_ = pp; asm volatile("" : "+s"(q_)); q_; })
#define PIN(i) (KP()->in[i])
#define ws (KP()->ws)
#define XRES (KP()->out)
#define H ((bf16_t*)(ws + WS_H))
#define P ((bf16_t*)(ws + WS_P))
#define YMIX ((float*)(ws + WS_YMIX))
#define ACT ((bf16_t*)(ws + WS_ACT))
#define tid ({ int t_ = wave_s * 64 + (int)__builtin_amdgcn_mbcnt_hi(~0u, __builtin_amdgcn_mbcnt_lo(~0u, 0u)); asm volatile("" : "+v"(t_)); t_; })
#define lane (tid & 63)
#define wid (__builtin_amdgcn_readfirstlane(tid >> 6))
#define gw (bid * NWAVES + wid)
#define gt (bid * NTHREADS + tid)
#define GBAR() do { XcdBarrier xb_; xb_.bar = (unsigned*)(ws + WS_BAR); xb_.x = xcc; xb_.st = (volatile LAS unsigned*)(lds + STAGE_BYTES); xcd_barrier(xb_, tid); } while (0)

template <int layer>
__device__ __forceinline__ void layer_body(CParams* pp, const int wave_s, LAS unsigned char* lds, const unsigned xcc) {
    const int G = gridDim.x, bid = blockIdx.x;
    const int NGW = G * NWAVES, NGT = G * NTHREADS;
        const int li = layer >> 1;
        if ((layer & 1) == 0) {
            const float* mu = PIN(2) + (size_t)li * 3360;
            { Gemm g{H, (const bf16_t*)(ws + WS_EVIN + li * SZ_EVIN), DM, DM, 0, 0}; StaticOrder S; S.init(MTOK, EVIN_NP, G, bid);
              EpiBf16 E{P, EVIN_NP}; gemm_phase<EpiBf16>(lds, g, S, E, tid); }
            GBAR();
            {
                bf16_t* LRA = (bf16_t*)(ws + WS_LRACT);
                for (int i = gt; i < MTOK * LRK; i += NGT) {
                    const int m = i / LRK, j = i % LRK; float v = 0.f;
                    if (j < 288) { const int col = 4096 + j; const float z = __uint_as_float((unsigned)P[(size_t)m * EVIN_NP + col] << 16);
                        const float zp = (m & (TSEQ - 1)) ? __uint_as_float((unsigned)P[(size_t)(m - 1) * EVIN_NP + col] << 16) : 0.f;
                        const float zz = z + (zp - z) * mu[col - 1024];
                        v = (j < 64) ? (2.0f * sigm(2.0f * zz) - 1.0f) : ((j < 128) ? zz : sigm(zz)); }
                    LRA[i] = (bf16_t)(cvt_pk_bf16(v, 0.f) & 0xffffu);
                }
            }
            GBAR();
            { Gemm g{(const bf16_t*)(ws + WS_LRACT), (const bf16_t*)(ws + WS_LR + li * SZ_LR), LRK, LRK, 0, 0}; StaticOrder S; S.init(MTOK, 3072, G, bid);
              EpiLR E{(float*)(ws + WS_DEC), (bf16_t*)(ws + WS_AB), (bf16_t*)(ws + WS_GB), PIN(12) + li * 1024, PIN(14) + li * 1024}; gemm_phase<EpiLR>(lds, g, S, E, tid); }
            GBAR();
            for (int wi = bid; wi < 256; wi += G) {
                if (wi < 128) rwkv_scan(lds, wi, P, (const float*)(ws + WS_DEC), (const bf16_t*)(ws + WS_AB), (float*)(ws + WS_YRAW), mu, PIN(17) + li * 1024, PIN(18) + li * 1024, tid);
                else s5_scan(lds, wi - 128, P, (bf16_t*)(ws + WS_Y5), PIN(3) + li * 4096, PIN(4) + li * 4096, PIN(5) + li * 64,
                             PIN(6) + (size_t)li * 65536, PIN(7) + (size_t)li * 65536, PIN(8) + (size_t)li * 65536, PIN(9) + (size_t)li * 65536, PIN(10) + li * 1024, tid);
                __syncthreads();
            }
            GBAR();
            {
                Gemm g{(const bf16_t*)(ws + WS_Y5), (const bf16_t*)(ws + WS_GLU + li * SZ_GLU), 1024, 1024, 0, 0}; StaticOrder S; S.init(MTOK, 1024, G, bid);
                EpiGLU E{(const bf16_t*)(ws + WS_Y5), (bf16_t*)(ws + WS_YCAT)}; gemm_phase<EpiGLU>(lds, g, S, E, tid);
                if (bid >= 128 || G < 256) {
                    const int nb = (G < 256) ? G : (G - 128), b0 = (G < 256) ? bid : (bid - 128);
                    rwkv_post(b0 * NTHREADS + tid, nb * NTHREADS, (const float*)(ws + WS_YRAW), P, (const bf16_t*)(ws + WS_AB), (const bf16_t*)(ws + WS_GB), (bf16_t*)(ws + WS_YCAT),
                              mu, PIN(18) + li * 1024, PIN(19) + li * 1024, PIN(20) + li * 1024, PIN(21) + li * 1024);
                }
            }
            GBAR();
            { Gemm g{(const bf16_t*)(ws + WS_YCAT), (const bf16_t*)(ws + WS_EVOUT + li * SZ_SQ), DM, DM, 0, 0}; StaticOrder S; S.init(MTOK, DM, G, bid);
              EpiF32 E{YMIX, DM}; gemm_phase<EpiF32>(lds, g, S, E, tid); }
            GBAR();
        } else {
            bf16_t* GATE = (bf16_t*)(ws + WS_GATE); bf16_t* XB = (bf16_t*)(ws + WS_XB); bf16_t* XC = (bf16_t*)(ws + WS_XC);
            { Gemm g{H, (const bf16_t*)(ws + WS_ODIN + li * SZ_ODIN), DM, DM, 0, 0}; StaticOrder S; S.init(MTOK, 4096, G, bid);
              EpiOddIn E{GATE, XB}; gemm_phase<EpiOddIn>(lds, g, S, E, tid); }
            GBAR();
            {
                const float* cw = PIN(24) + (size_t)li * 4 * DM; const float* cb = PIN(25) + (size_t)li * DM;
                for (int i = gt; i < MTOK * (DM / 8); i += NGT) {
                    const int m = i >> 8, c8 = (i & 255) * 8, t = m & (TSEQ - 1);
                    float acc[8];
#pragma unroll
                    for (int j = 0; j < 8; ++j) acc[j] = cb[c8 + j];
#pragma unroll
                    for (int q = 0; q < 4; ++q) {
                        if (t - 3 + q >= 0) { const u32x4 xw = *(const u32x4*)(XB + (size_t)(m - 3 + q) * DM + c8); float xv[8]; unpack8(xw, xv);
#pragma unroll
                            for (int j = 0; j < 8; ++j) acc[j] += cw[q * DM + c8 + j] * xv[j]; }
                    }
                    *(u32x4*)(XC + (size_t)m * DM + c8) = pack8(acc);
                }
            }
            GBAR();
            { Gemm g{XC, (const bf16_t*)(ws + WS_GATES + li * SZ_GATES), DM, 256, 1, 256}; StaticOrder S; S.init(MTOK, 4096, G, bid);
              EpiGates E{XC, (float*)(ws + WS_AA), (float*)(ws + WS_BX), PIN(27) + li * DM, PIN(29) + li * DM, PIN(30) + li * DM}; gemm_phase<EpiGates>(lds, g, S, E, tid); }
            GBAR();
            for (int wi = bid; wi < 128; wi += G) lru_scan(lds, wi, (const float*)(ws + WS_AA), (const float*)(ws + WS_BX), GATE, XB  , tid);
            GBAR();
            { Gemm g{XB  , (const bf16_t*)(ws + WS_ODOUT + li * SZ_SQ), DM, DM, 0, 0}; StaticOrder S; S.init(MTOK, DM, G, bid);
              EpiF32 E{YMIX, DM}; gemm_phase<EpiF32>(lds, g, S, E, tid); }
            GBAR();
        }
        norm_rows(YMIX, XRES, XRES, PIN(36) + layer * DM, PIN(37) + layer * DM, H, gw, NGW, lane);
        GBAR();
        { Gemm g{H, (const bf16_t*)(ws + WS_GU + layer * SZ_GU), DM, DM, 0, 0}; StaticOrder S; S.init(MTOK, 2 * DFF, G, bid);
          EpiGU E{ACT}; gemm_phase<EpiGU>(lds, g, S, E, tid); }
        GBAR();
        { Gemm g{ACT, (const bf16_t*)(ws + WS_DN + layer * SZ_DN), DFF, DFF, 0, 0}; StaticOrder S; S.init(MTOK, DM, G, bid);
          EpiF32 E{YMIX, DM}; gemm_phase<EpiF32>(lds, g, S, E, tid); }
        GBAR();
        norm_rows(YMIX, XRES, XRES, PIN(38) + layer * DM, (layer < 3) ? (PIN(35) + (layer + 1) * DM) : nullptr, H, gw, NGW, lane);
        if (layer < 3) GBAR();
}

__global__ void __launch_bounds__(NTHREADS) mega_fwd(Params p) {
    extern __shared__ __attribute__((aligned(16))) unsigned char lds_raw[];
    LAS unsigned char* lds = (LAS unsigned char*)lds_raw;
    cg::grid_group grid = cg::this_grid();
    if (threadIdx.x < 16) ((LAS unsigned*)(lds + STAGE_BYTES))[threadIdx.x] = 0u;
    __syncthreads();
    const unsigned xcc = xb_xcc_id();
    CParams* pp = (CParams*)__builtin_amdgcn_kernarg_segment_ptr();
    if (threadIdx.x == 0) (void)xb_add(&((unsigned*)(ws + WS_BAR))[XB_XCNT(xcc)], 1u);
    const int wave_s = __builtin_amdgcn_readfirstlane(threadIdx.x >> 6);
    const int G = gridDim.x, bid = blockIdx.x;
    const int NGW = G * NWAVES, NGT = G * NTHREADS;

    {
        LAS float* scr = (LAS float*)(lds + wid * 8448);
        for (int e = 0; e < 2; ++e) {
            bf16_t* wevin = (bf16_t*)(ws + WS_EVIN + e * SZ_EVIN);
            TR_JOB(PIN(1) + (size_t)e * DM * EVIN_N, EVIN_N, DM, EVIN_N, wevin, DM, nl);
            for (int i = gt; i < (EVIN_NP - EVIN_N) * DM / 8; i += NGT) *(u32x4*)(wevin + (size_t)EVIN_N * DM + (size_t)i * 8) = (u32x4){0u, 0u, 0u, 0u};
            TR_JOB(PIN(11) + (size_t)e * 1024 * 1024, 1024, 1024, 1024, (bf16_t*)(ws + WS_GLU + e * SZ_GLU), 1024, nl);
            TR_JOB(PIN(22) + (size_t)e * DM * DM, DM, DM, DM, (bf16_t*)(ws + WS_EVOUT + e * SZ_SQ), DM, nl);
            {
                bf16_t* wlr = (bf16_t*)(ws + WS_LR + e * SZ_LR);
                const float* w2 = PIN(13) + (size_t)e * 64 * 1024; const float* a2 = PIN(15) + (size_t)e * 64 * 1024; const float* g2 = PIN(16) + (size_t)e * 160 * 1024;
                for (int i = gt; i < 3072 * (LRK / 8); i += NGT) {
                    const int n = i / (LRK / 8), k8 = (i % (LRK / 8)) * 8, type = n >> 10, nn = n & 1023;
                    float o[8];
#pragma unroll
                    for (int j = 0; j < 8; ++j) { const int k = k8 + j; float v = 0.f;
                        if (type == 0) { if (k < 64) v = w2[(size_t)k * 1024 + nn]; }
                        else if (type == 1) { if (k >= 64 && k < 128) v = a2[(size_t)(k - 64) * 1024 + nn]; }
                        else { if (k >= 128 && k < 288) v = g2[(size_t)(k - 128) * 1024 + nn]; }
                        o[j] = v; }
                    *(u32x4*)(wlr + (size_t)n * LRK + k8) = pack8(o);
                }
            }
        }
        for (int o = 0; o < 2; ++o) {
            TR_JOB(PIN(23) + (size_t)o * DM * 4096, 4096, DM, 4096, (bf16_t*)(ws + WS_ODIN + o * SZ_ODIN), DM, nl);
            TR_JOB(PIN(31) + (size_t)o * DM * DM, DM, DM, DM, (bf16_t*)(ws + WS_ODOUT + o * SZ_SQ), DM, nl);
            bf16_t* wg = (bf16_t*)(ws + WS_GATES + o * SZ_GATES);
            for (int it = gw; it < 16 * 32; it += NGW) {
                const int job = it >> 5, sub = it & 31, blk = job >> 1, ri = job & 1, kb = sub >> 3, nl = (sub & 7) * 32;
                const float* W = (ri ? PIN(28) : PIN(26)) + (size_t)(o * 8 + blk) * 65536;
                tr_item(W, 256, kb * 64, nl, wg, 256, (2 * blk + (nl >> 7)) * 256 + ri * 128 + (nl & 127), kb * 64, scr, lane);
            }
        }
        for (int l = 0; l < 4; ++l) {
            bf16_t* wgu = (bf16_t*)(ws + WS_GU + l * SZ_GU);
            TR_JOB(PIN(32) + (size_t)l * DM * DFF, DFF, DM, DFF, wgu, DM, (nl >> 7) * 256 + (nl & 127));
            TR_JOB(PIN(33) + (size_t)l * DM * DFF, DFF, DM, DFF, wgu, DM, (nl >> 7) * 256 + 128 + (nl & 127));
            TR_JOB(PIN(34) + (size_t)l * DFF * DM, DM, DFF, DM, (bf16_t*)(ws + WS_DN + l * SZ_DN), DFF, nl);
        }
        norm_rows(nullptr, PIN(0), XRES, nullptr, PIN(35), H, gw, NGW, lane);
    }
    grid.sync();

    layer_body<0>(pp, wave_s, lds, xcc);
    layer_body<1>(pp, wave_s, lds, xcc);
    layer_body<2>(pp, wave_s, lds, xcc);
    layer_body<3>(pp, wave_s, lds, xcc);
}

#undef KP
#undef PIN
#undef ws
#undef XRES
#undef H
#undef P
#undef YMIX
#undef ACT
#undef tid
#undef lane
#undef wid
#undef gw
#undef gt
#undef GBAR

extern "C" void kernel_launch(void* const* d_in, const int* in_sizes, int n_in, void* d_out, int out_size, void* d_ws, size_t ws_size, hipStream_t stream) {
    static int grid = 0;
    if (grid == 0) {
        if (n_in != 39 || out_size != MTOK * DM || ws_size < WS_END) { fprintf(stderr, "kernel_launch: unexpected shapes (n_in %d out %d ws %zu need %zu)\n", n_in, out_size, ws_size, (size_t)WS_END); grid = -1; return; }
        int dev = 0, cus = 0, per_cu = 0;
        (void)hipGetDevice(&dev);
        (void)hipDeviceGetAttribute(&cus, hipDeviceAttributeMultiprocessorCount, dev);
        if (hipFuncSetAttribute((const void*)mega_fwd, hipFuncAttributeMaxDynamicSharedMemorySize, LDS_BYTES) != hipSuccess) { fprintf(stderr, "kernel_launch: hipFuncSetAttribute failed\n"); grid = -1; return; }
        if (hipOccupancyMaxActiveBlocksPerMultiprocessor(&per_cu, (const void*)mega_fwd, NTHREADS, LDS_BYTES) != hipSuccess || per_cu < 1) { fprintf(stderr, "kernel_launch: occupancy query gave %d\n", per_cu); per_cu = 1; }
        (void)hipGetLastError();
        grid = cus * 1;
    }
    if (grid < 0) return;
    if (hipMemsetAsync((char*)d_ws + WS_BAR, 0, 16384, stream) != hipSuccess) { fprintf(stderr, "kernel_launch: memset failed\n"); return; }
    Params p{};
    for (int i = 0; i < 39; ++i) p.in[i] = (const float*)d_in[i];
    p.out = (float*)d_out; p.ws = (unsigned char*)d_ws;
    void* args[] = {&p};
    hipError_t e = hipLaunchCooperativeKernel((const void*)mega_fwd, dim3(grid), dim3(NTHREADS), args, LDS_BYTES, stream);
    if (e != hipSuccess) fprintf(stderr, "cooperative launch failed: %s (grid %d)\n", hipGetErrorString(e), grid);
}
```

```cpp
#include <hip/hip_runtime.h>
#include <hip/hip_cooperative_groups.h>
#include <cstdio>
namespace cg = cooperative_groups;

#define LAS __attribute__((address_space(3)))
typedef unsigned short bf16_t;
typedef short bf16x8 __attribute__((ext_vector_type(8)));
typedef float f32x4 __attribute__((ext_vector_type(4)));
typedef unsigned u32x4 __attribute__((ext_vector_type(4)));
typedef unsigned u32x2 __attribute__((ext_vector_type(2)));

constexpr int MTOK = 8192, TSEQ = 4096, DM = 2048, DFF = 5632;
constexpr int EVIN_N = 4384, EVIN_NP = 4608, LRK = 384;
constexpr int NTHREADS = 512, NWAVES = 8;
constexpr int BM = 256, BK = 64, HALF = 128, HTB = HALF * BK * 2, STAGE_BYTES = 8 * HTB, NXCD = 8, WGM = 8;
constexpr int LDS_BYTES = STAGE_BYTES + 64;

constexpr size_t al256(size_t x) { return (x + 255) & ~(size_t)255; }
constexpr size_t SZ_EVIN = (size_t)EVIN_NP * DM * 2, SZ_GLU = (size_t)1024 * 1024 * 2, SZ_LR = (size_t)3072 * LRK * 2, SZ_SQ = (size_t)DM * DM * 2;
constexpr size_t SZ_ODIN = (size_t)4096 * DM * 2, SZ_GATES = (size_t)4096 * 256 * 2, SZ_GU = (size_t)2 * DFF * DM * 2, SZ_DN = (size_t)DM * DFF * 2;
constexpr size_t WS_EVIN = 0;
constexpr size_t WS_GLU = WS_EVIN + 2 * SZ_EVIN;
constexpr size_t WS_LR = WS_GLU + 2 * SZ_GLU;
constexpr size_t WS_EVOUT = WS_LR + 2 * SZ_LR;
constexpr size_t WS_ODIN = WS_EVOUT + 2 * SZ_SQ;
constexpr size_t WS_GATES = WS_ODIN + 2 * SZ_ODIN;
constexpr size_t WS_ODOUT = WS_GATES + 2 * SZ_GATES;
constexpr size_t WS_GU = WS_ODOUT + 2 * SZ_SQ;
constexpr size_t WS_DN = WS_GU + 4 * SZ_GU;
constexpr size_t WS_H = WS_DN + 4 * SZ_DN;
constexpr size_t WS_P = WS_H + (size_t)MTOK * DM * 2;
constexpr size_t WS_YMIX = WS_P + (size_t)MTOK * EVIN_NP * 2;
constexpr size_t WS_ACT = WS_YMIX + (size_t)MTOK * DM * 4;
constexpr size_t WS_MIX2 = WS_ACT + (size_t)MTOK * DFF * 2;
constexpr size_t WS_BAR = WS_MIX2 + (size_t)MTOK * DM * 4;
constexpr size_t WS_END = WS_BAR + 16384;
constexpr size_t WS_LRACT = WS_ACT;
constexpr size_t WS_DEC = WS_LRACT + (size_t)MTOK * LRK * 2;
constexpr size_t WS_AB = WS_DEC + (size_t)MTOK * 1024 * 4;
constexpr size_t WS_GB = WS_AB + (size_t)MTOK * 1024 * 2;
constexpr size_t WS_Y5 = WS_GB + (size_t)MTOK * 1024 * 2;
static_assert(WS_Y5 + (size_t)MTOK * 1024 * 2 <= WS_MIX2, "even temporaries overflow ACT");
constexpr size_t WS_YRAW = WS_MIX2;
constexpr size_t WS_YCAT = WS_MIX2 + (size_t)MTOK * 1024 * 4;
constexpr size_t WS_GATE = WS_P;
constexpr size_t WS_XB = WS_P + (size_t)MTOK * DM * 2;
constexpr size_t WS_XC = WS_YMIX;
constexpr size_t WS_AA = WS_ACT;
constexpr size_t WS_BX = WS_MIX2;

struct Params { const float* in[39]; float* out; unsigned char* ws; };

__device__ __forceinline__ unsigned cvt_pk_bf16(float lo, float hi) { unsigned r; asm volatile("v_cvt_pk_bf16_f32 %0, %1, %2" : "=v"(r) : "v"(lo), "v"(hi)); return r; }
__device__ __forceinline__ float bflo(unsigned w) { return __uint_as_float(w << 16); }
__device__ __forceinline__ float bfhi(unsigned w) { return __uint_as_float(w & 0xffff0000u); }
__device__ __forceinline__ float sigm(float x) { return __builtin_amdgcn_rcpf(1.0f + __expf(-x)); }
__device__ __forceinline__ float gelu_t(float x) { return x * sigm(1.5957691216057308f * (x + 0.044715f * x * x * x)); }
__device__ __forceinline__ float softplus_f(float z) { return fmaxf(z, 0.f) + __logf(1.0f + __expf(-fabsf(z))); }
__device__ __forceinline__ void unpack8(const u32x4 w, float (&f)[8]) {
    f[0] = bflo(w.x); f[1] = bfhi(w.x); f[2] = bflo(w.y); f[3] = bfhi(w.y); f[4] = bflo(w.z); f[5] = bfhi(w.z); f[6] = bflo(w.w); f[7] = bfhi(w.w);
}
__device__ __forceinline__ u32x4 pack8(const float (&f)[8]) { u32x4 w; w.x = cvt_pk_bf16(f[0], f[1]); w.y = cvt_pk_bf16(f[2], f[3]); w.z = cvt_pk_bf16(f[4], f[5]); w.w = cvt_pk_bf16(f[6], f[7]); return w; }
__device__ __forceinline__ float wave_sum(float v) {
#pragma unroll
    for (int o = 1; o < 64; o <<= 1) v += __shfl_xor(v, o);
    return v;
}
template <int CTRL> __device__ __forceinline__ float dpp_f(float x) { return __int_as_float(__builtin_amdgcn_update_dpp(0, __float_as_int(x), CTRL, 0xf, 0xf, true)); }
__device__ __forceinline__ float row16_sum(float x) {
    x += dpp_f<0xB1>(x);
    x += dpp_f<0x4E>(x);
    x += dpp_f<0x141>(x);
    x += dpp_f<0x140>(x);
    return x;
}
#define LDS_WAIT() asm volatile("s_waitcnt lgkmcnt(0)" ::: "memory")

__device__ __forceinline__ int lds_byte(int r, int c) { const int st = (r >> 4) * 2 + (c >> 5), rr = r & 15, cc = c & 31, ob = rr * 64 + cc * 2; return st * 1024 + (ob ^ (((ob >> 9) & 1) << 5)); }
__device__ __forceinline__ void stage_rc(int b, int& R, int& C) { const int st = b / 1024, sb = b % 1024, swz = sb ^ (((sb >> 9) & 1) << 5); R = (st >> 1) * 16 + swz / 64; C = (st & 1) * 32 + (swz % 64) / 2; }
__device__ __forceinline__ int perm32(int rho) { const int n = rho >> 4, i = rho & 15; return 8 * (i >> 2) + 4 * n + (i & 3); }

struct Unit { int pm, pn; };
struct Gemm { const bf16_t* A; const bf16_t* Bt; int lda, K, apn_shift, apn_mul; };
struct StaticOrder {
    int nM, nN, nwg, G, c;
    __device__ void init(int M, int N, int G_, int c_) { nM = M / BM; nN = N / BM; nwg = nM * nN; G = G_; c = c_; }
    __device__ bool next(int i, Unit& u) const {
        const long L = (long)i * G + c; if (L >= nwg) return false;
        int wgid = (int)L; { const int q = nwg / NXCD, r = nwg % NXCD, xcd = wgid % NXCD, off = wgid / NXCD; wgid = (xcd < r ? xcd * (q + 1) : r * (q + 1) + (xcd - r) * q) + off; }
        const int nig = WGM * nN, gid = wgid / nig, fm = gid * WGM, gsz = (nM - fm) < WGM ? (nM - fm) : WGM;
        u.pm = fm + ((wgid % nig) % gsz); u.pn = (wgid % nig) / gsz; return true;
    }
};

struct EpiF32 {
    static constexpr bool PERM = false;
    float* C; int ldc;
    __device__ __forceinline__ void operator()(const f32x4 (&acc)[2][2][4][2], const Unit& u, int wr, int wc, int fr, int fq) const {
        const int row0 = u.pm * BM + wr * 64 + fr, col0 = u.pn * BM + wc * 32 + 4 * fq;
#pragma unroll
        for (int ai = 0; ai < 2; ++ai)
#pragma unroll
            for (int m = 0; m < 4; ++m) { float* rowp = C + (size_t)(row0 + ai * HALF + m * 16) * ldc + col0;
#pragma unroll
                for (int bj = 0; bj < 2; ++bj)
#pragma unroll
                    for (int n = 0; n < 2; ++n) *(f32x4*)(rowp + bj * HALF + n * 16) = acc[ai][bj][m][n]; }
    }
};
struct EpiBf16 {
    static constexpr bool PERM = true;
    bf16_t* O; int ldc;
    __device__ __forceinline__ void operator()(const f32x4 (&acc)[2][2][4][2], const Unit& u, int wr, int wc, int fr, int fq) const {
        const int row0 = u.pm * BM + wr * 64 + fr, col0 = u.pn * BM + wc * 32 + 8 * fq;
#pragma unroll
        for (int ai = 0; ai < 2; ++ai)
#pragma unroll
            for (int m = 0; m < 4; ++m) { bf16_t* rowp = O + (size_t)(row0 + ai * HALF + m * 16) * ldc + col0;
#pragma unroll
                for (int bj = 0; bj < 2; ++bj) { const f32x4 v0 = acc[ai][bj][m][0], v1 = acc[ai][bj][m][1];
                    u32x4 w; w.x = cvt_pk_bf16(v0[0], v0[1]); w.y = cvt_pk_bf16(v0[2], v0[3]); w.z = cvt_pk_bf16(v1[0], v1[1]); w.w = cvt_pk_bf16(v1[2], v1[3]);
                    *(u32x4*)(rowp + bj * HALF) = w; } }
    }
};
struct EpiOddIn {
    static constexpr bool PERM = true;
    bf16_t* GATE; bf16_t* XB;
    __device__ __forceinline__ void operator()(const f32x4 (&acc)[2][2][4][2], const Unit& u, int wr, int wc, int fr, int fq) const {
        const bool isg = u.pn < 8; bf16_t* base = isg ? GATE : XB;
        const int row0 = u.pm * BM + wr * 64 + fr, col0 = (u.pn & 7) * BM + wc * 32 + 8 * fq;
#pragma unroll
        for (int ai = 0; ai < 2; ++ai)
#pragma unroll
            for (int m = 0; m < 4; ++m) { bf16_t* rowp = base + (size_t)(row0 + ai * HALF + m * 16) * DM + col0;
#pragma unroll
                for (int bj = 0; bj < 2; ++bj) { f32x4 v0 = acc[ai][bj][m][0], v1 = acc[ai][bj][m][1];
                    if (isg) {
#pragma unroll
                        for (int j = 0; j < 4; ++j) { v0[j] = gelu_t(v0[j]); v1[j] = gelu_t(v1[j]); } }
                    u32x4 w; w.x = cvt_pk_bf16(v0[0], v0[1]); w.y = cvt_pk_bf16(v0[2], v0[3]); w.z = cvt_pk_bf16(v1[0], v1[1]); w.w = cvt_pk_bf16(v1[2], v1[3]);
                    *(u32x4*)(rowp + bj * HALF) = w; } }
    }
};
struct EpiLR {
    static constexpr bool PERM = true;
    float* DEC; bf16_t* AB; bf16_t* GB; const float* w0; const float* a0;
    __device__ __forceinline__ void operator()(const f32x4 (&acc)[2][2][4][2], const Unit& u, int wr, int wc, int fr, int fq) const {
        const int type = u.pn >> 2;
        bf16_t* obase = AB; if (type == 2) obase = GB;
        const int row0 = u.pm * BM + wr * 64 + fr, col0 = (u.pn & 3) * BM + wc * 32 + 8 * fq;
#pragma unroll
        for (int bj = 0; bj < 2; ++bj) {
            const int col = col0 + bj * HALF;
            f32x4 c0 = (f32x4){0.f, 0.f, 0.f, 0.f}, c1 = c0;
            if (type == 0) { c0 = *(const f32x4*)(w0 + col); c1 = *(const f32x4*)(w0 + col + 4); }
            else if (type == 1) { c0 = *(const f32x4*)(a0 + col); c1 = *(const f32x4*)(a0 + col + 4); }
#pragma unroll
            for (int ai = 0; ai < 2; ++ai)
#pragma unroll
                for (int m = 0; m < 4; ++m) {
                    const size_t off = (size_t)(row0 + ai * HALF + m * 16) * 1024 + col;
                    f32x4 v0 = acc[ai][bj][m][0] + c0, v1 = acc[ai][bj][m][1] + c1;
                    if (type == 0) {
#pragma unroll
                        for (int j = 0; j < 4; ++j) { v0[j] = __expf(-__expf(-softplus_f(-v0[j]) - 0.5f)); v1[j] = __expf(-__expf(-softplus_f(-v1[j]) - 0.5f)); }
                        *(f32x4*)(DEC + off) = v0; *(f32x4*)(DEC + off + 4) = v1;
                    } else {
                        if (type == 1) {
#pragma unroll
                            for (int j = 0; j < 4; ++j) { v0[j] = sigm(v0[j]); v1[j] = sigm(v1[j]); } }
                        u32x4 w; w.x = cvt_pk_bf16(v0[0], v0[1]); w.y = cvt_pk_bf16(v0[2], v0[3]); w.z = cvt_pk_bf16(v1[0], v1[1]); w.w = cvt_pk_bf16(v1[2], v1[3]);
                        *(u32x4*)(obase + off) = w;
                    }
                }
        }
    }
};
struct EpiGLU {
    static constexpr bool PERM = true;
    const bf16_t* Y5; bf16_t* YCAT;
    __device__ __forceinline__ void operator()(const f32x4 (&acc)[2][2][4][2], const Unit& u, int wr, int wc, int fr, int fq) const {
        const int row0 = u.pm * BM + wr * 64 + fr, col0 = u.pn * BM + wc * 32 + 8 * fq;
#pragma unroll
        for (int ai = 0; ai < 2; ++ai)
#pragma unroll
            for (int m = 0; m < 4; ++m) { const int row = row0 + ai * HALF + m * 16;
#pragma unroll
                for (int bj = 0; bj < 2; ++bj) { const f32x4 v0 = acc[ai][bj][m][0], v1 = acc[ai][bj][m][1];
                    const u32x4 yw = *(const u32x4*)(Y5 + (size_t)row * 1024 + col0 + bj * HALF);
                    float y[8]; unpack8(yw, y);
                    float o[8];
#pragma unroll
                    for (int j = 0; j < 4; ++j) { o[j] = y[j] * sigm(v0[j]); o[4 + j] = y[4 + j] * sigm(v1[j]); }
                    *(u32x4*)(YCAT + (size_t)row * DM + col0 + bj * HALF) = pack8(o); } }
    }
};
struct EpiGates {
    static constexpr bool PERM = true;
    const bf16_t* XC; unsigned* LAB; const float* b_r; const float* b_i; const float* lam;
    __device__ __forceinline__ void operator()(const f32x4 (&acc)[2][2][4][2], const Unit& u, int wr, int wc, int fr, int fq) const {
        const int row0 = u.pm * BM + wr * 64 + fr, ch0 = (u.pn >> 1) * 256 + (u.pn & 1) * 128 + wc * 32 + 8 * fq;
#pragma unroll
        for (int ai = 0; ai < 2; ++ai)
#pragma unroll
            for (int m = 0; m < 4; ++m) { const int row = row0 + ai * HALF + m * 16; const size_t off = (size_t)row * DM + ch0;
                const u32x4 xw = *(const u32x4*)(XC + off); float xc[8]; unpack8(xw, xc);
#pragma unroll
                for (int n = 0; n < 2; ++n) {
                    const f32x4 br = *(const f32x4*)(b_r + ch0 + 4 * n), bi = *(const f32x4*)(b_i + ch0 + 4 * n), lm = *(const f32x4*)(lam + ch0 + 4 * n);
                    u32x4 ov;
#pragma unroll
                    for (int j = 0; j < 4; ++j) {
                        const float gr = acc[ai][0][m][n][j] + br[j], gi = acc[ai][1][m][n][j] + bi[j];
                        const float la = -8.0f * sigm(gr) * softplus_f(-lm[j]);
                        const float mult = sqrtf(fmaxf(1.0f - __expf(2.0f * la), 0.f));
                        ov[j] = cvt_pk_bf16(la, mult * sigm(gi) * xc[4 * n + j]);
                    }
                    *(u32x4*)(LAB + off + 4 * n) = ov;
                } }
    }
};
struct EpiGU {
    static constexpr bool PERM = true;
    bf16_t* ACT;
    __device__ __forceinline__ void operator()(const f32x4 (&acc)[2][2][4][2], const Unit& u, int wr, int wc, int fr, int fq) const {
        const int row0 = u.pm * BM + wr * 64 + fr, col0 = u.pn * HALF + wc * 32 + 8 * fq;
#pragma unroll
        for (int ai = 0; ai < 2; ++ai)
#pragma unroll
            for (int m = 0; m < 4; ++m) { const int row = row0 + ai * HALF + m * 16;
                float o[8];
#pragma unroll
                for (int n = 0; n < 2; ++n)
#pragma unroll
                    for (int j = 0; j < 4; ++j) { const float g = acc[ai][0][m][n][j]; o[4 * n + j] = g * sigm(g) * acc[ai][1][m][n][j]; }
                *(u32x4*)(ACT + (size_t)row * DFF + col0) = pack8(o); }
    }
};

template <class Epi>
__device__ __forceinline__ void gemm_phase(LAS unsigned char* lds, const Gemm g, const StaticOrder& S, const Epi& E, int tid  ) {
    const int wid = __builtin_amdgcn_readfirstlane(tid >> 6), lane = tid & 63, wr = wid >> 2, wc = wid & 3, fr = lane & 15, fq = lane >> 4;
    const int K = g.K, nt = K / BK;
    unsigned voffA[2], voffB[2];
#pragma unroll
    for (int i = 0; i < 2; ++i) { int R, C; stage_rc(tid * 16 + i * 8192, R, C); const int Rb = Epi::PERM ? ((R & ~31) + perm32(R & 31)) : R;
        voffA[i] = (unsigned)(R * g.lda + C) * 2u; voffB[i] = (unsigned)(Rb * K + C) * 2u; }
    const size_t kstep = (size_t)(BK * 2);
    const size_t hstepA = (size_t)HALF * g.lda * 2, hstepB = (size_t)HALF * K * 2;
    const size_t tstepA = 2 * hstepA, tstepB = 2 * hstepB;
    const unsigned ldsw = (unsigned)wid * 1024u;
    const int aoff = lds_byte(wr * 64 + fr, fq * 8), boff = lds_byte(wc * 32 + fr, fq * 8);
#define PG8_SA(b, h) (((b) * 2 + (h)) * HTB)
#define PG8_SB(b, h) ((4 + (b) * 2 + (h)) * HTB)
#define PG8_STAGE(bufoff, gbase, voff) do { _Pragma("unroll") for (int _i = 0; _i < 2; ++_i) \
        __builtin_amdgcn_global_load_lds((const unsigned*)((const char*)(gbase) + (voff)[_i]), (LAS unsigned*)(lds + (bufoff) + ldsw + _i * 8192), 16, 0, 0); } while (0)
#define PG8_LDA(dst, b, h) do { _Pragma("unroll") for (int m = 0; m < 4; ++m) _Pragma("unroll") for (int k = 0; k < 2; ++k) dst[m][k] = *(const LAS bf16x8*)(lds + PG8_SA(b, h) + aoff + m * 2048 + k * 1024); } while (0)
#define PG8_LDB(dst, b, h) do { _Pragma("unroll") for (int n = 0; n < 2; ++n) _Pragma("unroll") for (int k = 0; k < 2; ++k) dst[n][k] = *(const LAS bf16x8*)(lds + PG8_SB(b, h) + boff + n * 2048 + k * 1024); } while (0)
#define PG8_MMA(ai, bj, At, Bt) do { __builtin_amdgcn_s_setprio(1); _Pragma("unroll") for (int m = 0; m < 4; ++m) _Pragma("unroll") for (int n = 0; n < 2; ++n) _Pragma("unroll") for (int k = 0; k < 2; ++k) \
        acc[ai][bj][m][n] = __builtin_amdgcn_mfma_f32_16x16x32_bf16(Bt[n][k], At[m][k], acc[ai][bj][m][n], 0, 0, 0); __builtin_amdgcn_s_setprio(0); } while (0)
#define PG8_WAIT_V(n) asm volatile("s_waitcnt vmcnt(" #n ")" ::: "memory")
#define PG8_WAIT_L(n) asm volatile("s_waitcnt lgkmcnt(" #n ")" ::: "memory")
#define PG8_BAR __builtin_amdgcn_s_barrier()
#define PG8_SCHED __builtin_amdgcn_sched_barrier(0)
#define PG8_AOF(u) ((const char*)g.A + (size_t)(u).pm * tstepA + (size_t)(((u).pn >> g.apn_shift) * g.apn_mul) * 2)
#define PG8_BOF(u) ((const char*)g.Bt + (size_t)(u).pn * tstepB)
    Unit cur, nxt; int ui = 0;
    if (!S.next(0, cur)) return;
    f32x4 acc[2][2][4][2];
#pragma unroll
    for (int a = 0; a < 2; ++a)
#pragma unroll
        for (int b = 0; b < 2; ++b)
#pragma unroll
            for (int m = 0; m < 4; ++m)
#pragma unroll
                for (int n = 0; n < 2; ++n) acc[a][b][m][n] = (f32x4){0.f, 0.f, 0.f, 0.f};
    bf16x8 At[4][2], B0[2][2], B1[2][2];
    const char* cA = PG8_AOF(cur); const char* cB = PG8_BOF(cur);
    PG8_STAGE(PG8_SB(0, 0), cB, voffB); PG8_STAGE(PG8_SA(0, 0), cA, voffA); PG8_STAGE(PG8_SB(0, 1), cB + hstepB, voffB); PG8_STAGE(PG8_SA(0, 1), cA + hstepA, voffA);
    if (wr == 1) PG8_BAR;
    PG8_WAIT_V(4); PG8_BAR;
    PG8_STAGE(PG8_SB(1, 0), cB + kstep, voffB); PG8_STAGE(PG8_SA(1, 0), cA + kstep, voffA); PG8_STAGE(PG8_SB(1, 1), cB + hstepB + kstep, voffB);
    PG8_WAIT_V(6); PG8_BAR;
    for (;;) {
        const bool has_next = S.next(ui + 1, nxt);
        const char* nA = has_next ? PG8_AOF(nxt) : cA; const char* nB = has_next ? PG8_BOF(nxt) : cB;
        for (int t = 0; t < nt; t += 2) {
            const bool last = (t == nt - 2);
            const char* a1 = cA + (size_t)(t + 1) * kstep;
            const char* a2 = last ? nA : cA + (size_t)(t + 2) * kstep; const char* b2 = last ? nB : cB + (size_t)(t + 2) * kstep;
            const char* a3 = a2 + kstep; const char* b3 = b2 + kstep;
            PG8_LDB(B0, 0, 0); PG8_SCHED; PG8_LDA(At, 0, 0); PG8_STAGE(PG8_SA(1, 1), a1 + hstepA, voffA);
            PG8_WAIT_L(8); PG8_BAR; PG8_WAIT_L(0); PG8_MMA(0, 0, At, B0); PG8_BAR; PG8_SCHED;
            PG8_LDB(B1, 0, 1); PG8_STAGE(PG8_SB(0, 0), b2, voffB);
            PG8_BAR; PG8_WAIT_L(0); PG8_MMA(0, 1, At, B1); PG8_BAR;
            PG8_LDA(At, 0, 1); PG8_STAGE(PG8_SA(0, 0), a2, voffA);
            PG8_BAR; PG8_WAIT_L(0); PG8_MMA(1, 0, At, B0); PG8_BAR; PG8_SCHED;
            PG8_STAGE(PG8_SB(0, 1), b2 + hstepB, voffB);
            PG8_WAIT_V(6); PG8_BAR; PG8_MMA(1, 1, At, B1); PG8_BAR;
            PG8_LDB(B0, 1, 0); PG8_SCHED; PG8_LDA(At, 1, 0); PG8_STAGE(PG8_SA(0, 1), a2 + hstepA, voffA);
            PG8_WAIT_L(8); PG8_BAR; PG8_WAIT_L(0); PG8_MMA(0, 0, At, B0); PG8_BAR; PG8_SCHED;
            PG8_LDB(B1, 1, 1); PG8_STAGE(PG8_SB(1, 0), b3, voffB);
            PG8_BAR; PG8_WAIT_L(0); PG8_MMA(0, 1, At, B1); PG8_BAR;
            PG8_LDA(At, 1, 1); PG8_STAGE(PG8_SA(1, 0), a3, voffA);
            PG8_BAR; PG8_WAIT_L(0); PG8_MMA(1, 0, At, B0); PG8_BAR; PG8_SCHED;
            PG8_STAGE(PG8_SB(1, 1), b3 + hstepB, voffB);
            PG8_WAIT_V(6); PG8_BAR; PG8_MMA(1, 1, At, B1); PG8_BAR;
        }
        E(acc, cur, wr, wc, fr, fq);
        if (!has_next) break;
#pragma unroll
        for (int a = 0; a < 2; ++a)
#pragma unroll
            for (int b = 0; b < 2; ++b)
#pragma unroll
                for (int m = 0; m < 4; ++m)
#pragma unroll
                    for (int n = 0; n < 2; ++n) acc[a][b][m][n] = (f32x4){0.f, 0.f, 0.f, 0.f};
        cur = nxt; cA = nA; cB = nB; ++ui;
    }
    PG8_WAIT_V(0);
    if (wr == 0) PG8_BAR;
    PG8_BAR;
#undef PG8_SA
#undef PG8_SB
#undef PG8_STAGE
#undef PG8_LDA
#undef PG8_LDB
#undef PG8_MMA
#undef PG8_WAIT_V
#undef PG8_WAIT_L
#undef PG8_BAR
#undef PG8_SCHED
#undef PG8_AOF
#undef PG8_BOF
}

__device__ __forceinline__ void tr_item(const float* W, int ldw, int k0, int n0, bf16_t* WT, int ldt, int drow0, int dk0, LAS float* scr, int lane) {
#pragma unroll
    for (int i = 0; i < 32; ++i) { const int kk = 2 * i + (lane >> 5); scr[kk * 33 + (lane & 31)] = W[(size_t)(k0 + kk) * ldw + n0 + (lane & 31)]; }
    LDS_WAIT(); asm volatile("" ::: "memory");
    const int c = lane & 7;
#pragma unroll
    for (int j = 0; j < 4; ++j) { const int n = (lane >> 3) + 8 * j; const LAS float* s = scr + (8 * c) * 33 + n;
        u32x4 o; o.x = cvt_pk_bf16(s[0 * 33], s[1 * 33]); o.y = cvt_pk_bf16(s[2 * 33], s[3 * 33]); o.z = cvt_pk_bf16(s[4 * 33], s[5 * 33]); o.w = cvt_pk_bf16(s[6 * 33], s[7 * 33]);
        *(u32x4*)(WT + (size_t)(drow0 + n) * ldt + dk0 + 8 * c) = o; }
    LDS_WAIT(); asm volatile("" ::: "memory");
}
#define TR_JOB(W, ldw, K, N, WT, ldt, DROW) do { const int nblk_ = (N) / 32, nit_ = ((K) / 64) * nblk_; \
    for (int it_ = gw; it_ < nit_; it_ += NGW) { const int kb_ = it_ / nblk_, nl = (it_ % nblk_) * 32; tr_item((W), (ldw), kb_ * 64, nl, (WT), (ldt), (DROW), kb_ * 64, scr, lane); } } while (0)

__device__ __forceinline__ void norm_rows(const float* Y, const float* Xin, float* Xout, const float* gpost, const float* gnext, bf16_t* H, int gw, int NGW, int lane) {
    for (int row = gw; row < MTOK; row += NGW) {
        const f32x4* xr = (const f32x4*)(Xin + (size_t)row * DM) + lane;
        f32x4 x[8];
#pragma unroll
        for (int j = 0; j < 8; ++j) x[j] = xr[64 * j];
        if (Y) {
            const f32x4* yr = (const f32x4*)(Y + (size_t)row * DM) + lane;
            f32x4 y[8]; float s = 0.f;
#pragma unroll
            for (int j = 0; j < 8; ++j) { y[j] = yr[64 * j]; s += (y[j][0] * y[j][0] + y[j][1] * y[j][1]) + (y[j][2] * y[j][2] + y[j][3] * y[j][3]); }
            const float rinv = rsqrtf(wave_sum(s) * (1.0f / DM) + 1e-6f);
#pragma unroll
            for (int j = 0; j < 8; ++j) { const f32x4 gp = *((const f32x4*)gpost + lane + 64 * j); x[j] = x[j] + y[j] * rinv * gp; }
        }
        if (Xout) { f32x4* xo = (f32x4*)(Xout + (size_t)row * DM) + lane;
#pragma unroll
            for (int j = 0; j < 8; ++j) xo[64 * j] = x[j]; }
        if (gnext) {
            float s = 0.f;
#pragma unroll
            for (int j = 0; j < 8; ++j) s += (x[j][0] * x[j][0] + x[j][1] * x[j][1]) + (x[j][2] * x[j][2] + x[j][3] * x[j][3]);
            const float rinv = rsqrtf(wave_sum(s) * (1.0f / DM) + 1e-6f);
            u32x2* ho = (u32x2*)(H + (size_t)row * DM) + lane;
#pragma unroll
            for (int j = 0; j < 8; ++j) { const f32x4 gn = *((const f32x4*)gnext + lane + 64 * j); const f32x4 v = x[j] * rinv * gn;
                u32x2 w; w.x = cvt_pk_bf16(v[0], v[1]); w.y = cvt_pk_bf16(v[2], v[3]); ho[64 * j] = w; }
        }
    }
}

typedef float f32x2 __attribute__((ext_vector_type(2)));
__device__ __forceinline__ void rwkv_scan(LAS unsigned char* ldsb, int wi, const bf16_t* P, const float* DEC, const bf16_t* AB, float* YRAW,
                                          const float* mu, const float* k_k, const float* k_a, int tid) {
    const int lane = tid & 63, wid = __builtin_amdgcn_readfirstlane(tid >> 6);
    const int b = wi >> 6, h = (wi >> 2) & 15, qr = wi & 3;
    constexpr int CH = 32, NCH = TSEQ / CH, ARR = CH * 64, BUF = 5 * ARR + 2 * CH * 16;
    LAS float* L = (LAS float*)ldsb;
    const int ptid = tid - 256, pt = (ptid >> 3) & 31, pc = (ptid & 7) * 8;
    const int hc = h * 64 + pc;
    const size_t mbase = (size_t)b * TSEQ;
    float mur[8], muk[8], muv[8], kkc[8], kac[8];
    u32x4 rc, rp, kc, kp, vc, vp, aw; f32x4 d0, d1;
    const u32x4 z4 = (u32x4){0u, 0u, 0u, 0u};
#define RW_LOAD(ch) do { const size_t m_ = mbase + (size_t)(ch) * CH + pt; const bf16_t* pr_ = P + m_ * EVIN_NP + 1024 + hc; const bool hp_ = ((ch) * CH + pt) > 0; \
        rc = *(const u32x4*)(pr_); kc = *(const u32x4*)(pr_ + 1024); vc = *(const u32x4*)(pr_ + 2048); \
        rp = hp_ ? *(const u32x4*)(pr_ - EVIN_NP) : z4; kp = hp_ ? *(const u32x4*)(pr_ - EVIN_NP + 1024) : z4; vp = hp_ ? *(const u32x4*)(pr_ - EVIN_NP + 2048) : z4; \
        aw = *(const u32x4*)(AB + m_ * 1024 + hc); d0 = *(const f32x4*)(DEC + m_ * 1024 + hc); d1 = *(const f32x4*)(DEC + m_ * 1024 + hc + 4); } while (0)
#define RW_PREP(B_) do { LAS float* bb_ = (B_); float r[8], k[8], v[8], a[8], t8[8]; \
        unpack8(rc, r); unpack8(rp, t8); _Pragma("unroll") for (int j = 0; j < 8; ++j) r[j] = r[j] + (t8[j] - r[j]) * mur[j]; \
        unpack8(kc, k); unpack8(kp, t8); _Pragma("unroll") for (int j = 0; j < 8; ++j) k[j] = k[j] + (t8[j] - k[j]) * muk[j]; \
        unpack8(vc, v); unpack8(vp, t8); _Pragma("unroll") for (int j = 0; j < 8; ++j) v[j] = v[j] + (t8[j] - v[j]) * muv[j]; \
        unpack8(aw, a); float kk[8]; float ss = 0.f; \
        _Pragma("unroll") for (int j = 0; j < 8; ++j) { kk[j] = k[j] * kkc[j]; ss += kk[j] * kk[j]; } \
        ss += __shfl_xor(ss, 1); ss += __shfl_xor(ss, 2); ss += __shfl_xor(ss, 4); \
        const float rn = rsqrtf(fmaxf(ss, 1e-24f)); f32x4 o0, o1; LAS float* dst; \
        dst = bb_ + pt * 64 + pc; o0 = (f32x4){r[0], r[1], r[2], r[3]}; o1 = (f32x4){r[4], r[5], r[6], r[7]}; *(LAS f32x4*)dst = o0; *(LAS f32x4*)(dst + 4) = o1; \
        dst = bb_ + ARR + pt * 64 + pc; *(LAS f32x4*)dst = d0; *(LAS f32x4*)(dst + 4) = d1; \
        _Pragma("unroll") for (int j = 0; j < 4; ++j) { o0[j] = k[j] * (1.0f + (a[j] - 1.0f) * kac[j]); o1[j] = k[4 + j] * (1.0f + (a[4 + j] - 1.0f) * kac[4 + j]); } \
        dst = bb_ + 2 * ARR + pt * 64 + pc; *(LAS f32x4*)dst = o0; *(LAS f32x4*)(dst + 4) = o1; \
        _Pragma("unroll") for (int j = 0; j < 4; ++j) { o0[j] = -kk[j] * rn; o1[j] = -kk[4 + j] * rn; } \
        dst = bb_ + 3 * ARR + pt * 64 + pc; *(LAS f32x4*)dst = o0; *(LAS f32x4*)(dst + 4) = o1; \
        _Pragma("unroll") for (int j = 0; j < 4; ++j) { o0[j] = kk[j] * rn * a[j]; o1[j] = kk[4 + j] * rn * a[4 + j]; } \
        dst = bb_ + 4 * ARR + pt * 64 + pc; *(LAS f32x4*)dst = o0; *(LAS f32x4*)(dst + 4) = o1; \
        if ((pc >> 4) == qr) { dst = bb_ + 5 * ARR + pt * 16 + (pc & 15); o0 = (f32x4){v[0], v[1], v[2], v[3]}; o1 = (f32x4){v[4], v[5], v[6], v[7]}; *(LAS f32x4*)dst = o0; *(LAS f32x4*)(dst + 4) = o1; } } while (0)
#define RW_WOUT(ch) do { if (ptid < 128) { const int t_ = ptid >> 2, j4_ = (ptid & 3) * 4; const f32x4 yv_ = *(const LAS f32x4*)(L + ((ch) & 1) * BUF + 5 * ARR + CH * 16 + t_ * 16 + j4_); \
        *(f32x4*)(YRAW + (mbase + (size_t)(ch) * CH + t_) * 1024 + h * 64 + qr * 16 + j4_) = yv_; } } while (0)
    if (wid >= 4) {
#pragma unroll
        for (int j = 0; j < 8; ++j) { mur[j] = mu[hc + j]; muk[j] = mu[1024 + hc + j]; muv[j] = mu[2048 + hc + j]; kkc[j] = k_k[hc + j]; kac[j] = k_a[hc + j]; }
        RW_LOAD(0); RW_PREP(L); RW_LOAD(1);
    }
    __syncthreads();
    const int rowl = (wid & 3) * 4 + (lane >> 4), kq = (lane & 15) * 4;
    f32x2 s01 = (f32x2){0.f, 0.f}, s23 = (f32x2){0.f, 0.f};
    for (int c = 0; c < NCH; ++c) {
        if (wid < 4) {
            const LAS float* cb = L + (c & 1) * BUF + kq;
            const LAS float* vb = L + (c & 1) * BUF + 5 * ARR + rowl;
            LAS float* yb = L + (c & 1) * BUF + 5 * ARR + CH * 16 + rowl;
            const int lj = lane & 15;
            for (int t16 = 0; t16 < CH; t16 += 16) {
                float ykeep = 0.f;
#pragma unroll
                for (int tt = 0; tt < 16; ++tt) {
                    const int t = t16 + tt;
                    const f32x4 r4 = *(const LAS f32x4*)(cb + t * 64), w4 = *(const LAS f32x4*)(cb + ARR + t * 64), k4 = *(const LAS f32x4*)(cb + 2 * ARR + t * 64);
                    const f32x4 a4 = *(const LAS f32x4*)(cb + 3 * ARR + t * 64), b4 = *(const LAS f32x4*)(cb + 4 * ARR + t * 64);
                    const float vv = vb[t * 16];
                    const f32x2 vv2 = (f32x2){vv, vv};
                    const f32x2 pa = s01 * (f32x2){a4[0], a4[1]} + s23 * (f32x2){a4[2], a4[3]};
                    const f32x2 t01 = s01 * (f32x2){w4[0], w4[1]} + vv2 * (f32x2){k4[0], k4[1]};
                    const f32x2 t23 = s23 * (f32x2){w4[2], w4[3]} + vv2 * (f32x2){k4[2], k4[3]};
                    const float sa = row16_sum(pa[0] + pa[1]);
                    const f32x2 sa2 = (f32x2){sa, sa};
                    s01 = sa2 * (f32x2){b4[0], b4[1]} + t01;
                    s23 = sa2 * (f32x2){b4[2], b4[3]} + t23;
                    const f32x2 py = s01 * (f32x2){r4[0], r4[1]} + s23 * (f32x2){r4[2], r4[3]};
                    const float y = row16_sum(py[0] + py[1]);
                    ykeep = (lj == tt) ? y : ykeep;
                }
                yb[(t16 + lj) * 16] = ykeep;
            }
        } else {
            if (c + 1 < NCH) { RW_PREP(L + ((c + 1) & 1) * BUF); if (c + 2 < NCH) RW_LOAD(c + 2); }
            if (c > 0) RW_WOUT(c - 1);
        }
        __syncthreads();
    }
    if (wid >= 4) RW_WOUT(NCH - 1);
#undef RW_LOAD
#undef RW_PREP
#undef RW_WOUT
}

__device__ __forceinline__ void rwkv_post(int gt, int NGT, const float* YRAW, const bf16_t* P, const bf16_t* AB, const bf16_t* GB, bf16_t* YCAT,
                                          const float* mu, const float* k_a, const float* r_k, const float* lnw, const float* lnb) {
    for (int it = gt; it < MTOK * 128; it += NGT) {
        const int m = it >> 7, hc = (it & 127) * 8;
        const bf16_t* pr = P + (size_t)m * EVIN_NP + 1024 + hc; const bool hp = (m & (TSEQ - 1)) != 0;
        const u32x4 z4 = (u32x4){0u, 0u, 0u, 0u};
        const u32x4 rc = *(const u32x4*)pr, kc = *(const u32x4*)(pr + 1024), vc = *(const u32x4*)(pr + 2048);
        const u32x4 rp = hp ? *(const u32x4*)(pr - EVIN_NP) : z4, kp = hp ? *(const u32x4*)(pr - EVIN_NP + 1024) : z4, vp = hp ? *(const u32x4*)(pr - EVIN_NP + 2048) : z4;
        const u32x4 aw = *(const u32x4*)(AB + (size_t)m * 1024 + hc), gw_ = *(const u32x4*)(GB + (size_t)m * 1024 + hc);
        const f32x4 y0 = *(const f32x4*)(YRAW + (size_t)m * 1024 + hc), y1 = *(const f32x4*)(YRAW + (size_t)m * 1024 + hc + 4);
        float r[8], k[8], v[8], a[8], gg[8], t8[8], y[8];
        unpack8(rc, r); unpack8(rp, t8);
#pragma unroll
        for (int j = 0; j < 8; ++j) r[j] = r[j] + (t8[j] - r[j]) * mu[hc + j];
        unpack8(kc, k); unpack8(kp, t8);
#pragma unroll
        for (int j = 0; j < 8; ++j) k[j] = k[j] + (t8[j] - k[j]) * mu[1024 + hc + j];
        unpack8(vc, v); unpack8(vp, t8);
#pragma unroll
        for (int j = 0; j < 8; ++j) v[j] = v[j] + (t8[j] - v[j]) * mu[2048 + hc + j];
        unpack8(aw, a); unpack8(gw_, gg);
#pragma unroll
        for (int j = 0; j < 4; ++j) { y[j] = y0[j]; y[4 + j] = y1[j]; }
        float s = 0.f, bo = 0.f;
#pragma unroll
        for (int j = 0; j < 8; ++j) { s += y[j]; const float kx = k[j] * (1.0f + (a[j] - 1.0f) * k_a[hc + j]); bo += r[j] * kx * r_k[hc + j]; }
        s += __shfl_xor(s, 1); s += __shfl_xor(s, 2); s += __shfl_xor(s, 4);
        bo += __shfl_xor(bo, 1); bo += __shfl_xor(bo, 2); bo += __shfl_xor(bo, 4);
        const float mean = s * (1.0f / 64.0f);
        float q = 0.f;
#pragma unroll
        for (int j = 0; j < 8; ++j) { y[j] -= mean; q += y[j] * y[j]; }
        q += __shfl_xor(q, 1); q += __shfl_xor(q, 2); q += __shfl_xor(q, 4);
        const float rstd = rsqrtf(q * (1.0f / 64.0f) + 64e-5f);
        float o[8];
#pragma unroll
        for (int j = 0; j < 8; ++j) o[j] = (y[j] * rstd * lnw[hc + j] + lnb[hc + j] + bo * v[j]) * gg[j];
        *(u32x4*)(YCAT + (size_t)m * DM + 1024 + hc) = pack8(o);
    }
}

__device__ __forceinline__ void s5_scan(LAS unsigned char* ldsb, int pair, const bf16_t* P, bf16_t* Y5, const float* lam_re, const float* lam_im, const float* log_dt,
                                        const float* b_re, const float* b_im, const float* c_re, const float* c_im, const float* dsk, int tid) {
    const int lane = tid & 63, wid = __builtin_amdgcn_readfirstlane(tid >> 6), fr = lane & 15, fq = lane >> 4;
    const int b = pair >> 6, g = pair & 63;
    LAS float* BR = (LAS float*)ldsb;
    LAS float* BI = BR + 64 * 68;
    LAS bf16_t* SR = (LAS bf16_t*)(BI + 64 * 68);
    LAS bf16_t* SI = SR + 64 * 72;
    const float dt = __expf(log_dt[g]);
    const int tt = wid & 3, ri = wid >> 2;
    bf16x8 bfrag[4];
#pragma unroll
    for (int pt = 0; pt < 4; ++pt) {
        const int p = pt * 16 + fr;
        const float lr = lam_re[g * 64 + p], li = lam_im[g * 64 + p];
        const float mag = __expf(lr * dt), ang = li * dt;
        const float are = mag * cosf(ang), aim = mag * sinf(ang);
        const float den = lr * lr + li * li, nr = are - 1.0f, ni = aim;
        const float gre = (nr * lr + ni * li) / den, gim = (ni * lr - nr * li) / den;
        float o[8];
#pragma unroll
        for (int e = 0; e < 8; ++e) {
            float val = 0.f;
            if (fq < 2) { const float br = b_re[(size_t)(g * 64 + p) * 16 + fq * 8 + e], bi = b_im[(size_t)(g * 64 + p) * 16 + fq * 8 + e];
                val = ri ? (gre * bi + gim * br) : (gre * br - gim * bi); }
            o[e] = val;
        }
        const u32x4 w = pack8(o); bfrag[pt] = __builtin_bit_cast(bf16x8, w);
    }
    float are_, aim_;
    { const float lr = lam_re[g * 64 + lane], li = lam_im[g * 64 + lane]; const float mag = __expf(lr * dt), ang = li * dt; are_ = mag * cosf(ang); aim_ = mag * sinf(ang); }
    bf16x8 cfrag[4];
#pragma unroll
    for (int kk = 0; kk < 4; ++kk) {
        float o[8];
#pragma unroll
        for (int e = 0; e < 8; ++e) { const int p = (kk & 1) * 32 + fq * 8 + e; o[e] = (kk < 2) ? c_re[(size_t)(g * 16 + fr) * 64 + p] : -c_im[(size_t)(g * 16 + fr) * 64 + p]; }
        const u32x4 w = pack8(o); cfrag[kk] = __builtin_bit_cast(bf16x8, w);
    }
    const f32x4 d4 = *(const f32x4*)(dsk + g * 16 + fq * 4);
    float sre = 0.f, sim = 0.f;
    const size_t m0 = (size_t)b * TSEQ;
    const u32x4 z4 = (u32x4){0u, 0u, 0u, 0u};
    u32x4 ucur = (fq < 2) ? *(const u32x4*)(P + (m0 + tt * 16 + fr) * EVIN_NP + g * 16 + fq * 8) : z4;
    for (int ch = 0; ch < TSEQ / 64; ++ch) {
        const size_t mc = m0 + (size_t)ch * 64;
        u32x4 unext = z4;
        if (ch + 1 < TSEQ / 64 && fq < 2) unext = *(const u32x4*)(P + (mc + 64 + tt * 16 + fr) * EVIN_NP + g * 16 + fq * 8);
        u32x2 usk = (u32x2){0u, 0u};
        if (wid < 4) usk = *(const u32x2*)(P + (mc + wid * 16 + fr) * EVIN_NP + g * 16 + fq * 4);
        {
            const bf16x8 ufrag = __builtin_bit_cast(bf16x8, ucur);
            LAS float* dst = (ri ? BI : BR) + (tt * 16 + fq * 4) * 68 + fr;
#pragma unroll
            for (int pt = 0; pt < 4; ++pt) {
                f32x4 d = (f32x4){0.f, 0.f, 0.f, 0.f};
                d = __builtin_amdgcn_mfma_f32_16x16x32_bf16(ufrag, bfrag[pt], d, 0, 0, 0);
#pragma unroll
                for (int jj = 0; jj < 4; ++jj) dst[jj * 68 + pt * 16] = d[jj];
            }
        }
        __syncthreads();
        if (wid == 0) {
#pragma unroll
            for (int t8 = 0; t8 < 8; ++t8) {
                float xr[8], xi[8];
#pragma unroll
                for (int i = 0; i < 8; ++i) { xr[i] = BR[(t8 * 8 + i) * 68 + lane]; xi[i] = BI[(t8 * 8 + i) * 68 + lane]; }
#pragma unroll
                for (int i = 0; i < 8; ++i) {
                    const float nre = are_ * sre - aim_ * sim + xr[i], nim = are_ * sim + aim_ * sre + xi[i];
                    sre = nre; sim = nim;
                    const unsigned w = cvt_pk_bf16(sre, sim);
                    SR[(t8 * 8 + i) * 72 + lane] = (bf16_t)(w & 0xffffu); SI[(t8 * 8 + i) * 72 + lane] = (bf16_t)(w >> 16);
                }
            }
        }
        __syncthreads();
        if (wid < 4) {
            f32x4 d = (f32x4){0.f, 0.f, 0.f, 0.f};
#pragma unroll
            for (int kk = 0; kk < 4; ++kk) {
                const LAS bf16_t* src = ((kk < 2) ? SR : SI) + (wid * 16 + fr) * 72 + (kk & 1) * 32 + fq * 8;
                const bf16x8 sfrag = *(const LAS bf16x8*)src;
                d = __builtin_amdgcn_mfma_f32_16x16x32_bf16(cfrag[kk], sfrag, d, 0, 0, 0);
            }
            const float u0 = bflo(usk.x), u1 = bfhi(usk.x), u2 = bflo(usk.y), u3 = bfhi(usk.y);
            const float y0 = gelu_t(d[0] + d4[0] * u0), y1 = gelu_t(d[1] + d4[1] * u1), y2 = gelu_t(d[2] + d4[2] * u2), y3 = gelu_t(d[3] + d4[3] * u3);
            u32x2 w; w.x = cvt_pk_bf16(y0, y1); w.y = cvt_pk_bf16(y2, y3);
            *(u32x2*)(Y5 + (mc + wid * 16 + fr) * 1024 + g * 16 + fq * 4) = w;
        }
        ucur = unext;
    }
}

__device__ __forceinline__ void lru_scan(LAS unsigned char* ldsb, int wi, const unsigned* LAB, const bf16_t* GATE, bf16_t* HG, int tid) {
    const int c = tid & 15, seg = tid >> 4;
    const int b = wi >> 7, ch = (wi & 127) * 16 + c;
    LAS float* SA = (LAS float*)ldsb; LAS float* SH = SA + 512;
    const size_t base = ((size_t)b * TSEQ + (size_t)seg * 128) * DM + ch;
    float ls = 0.f, h = 0.f;
#pragma unroll 16
    for (int t = 0; t < 128; ++t) { const unsigned w = LAB[base + (size_t)t * DM]; const float la = bflo(w); h = __expf(la) * h + bfhi(w); ls += la; }
    SA[seg * 16 + c] = __expf(ls); SH[seg * 16 + c] = h;
    __syncthreads();
    float hin = 0.f;
    for (int s = 0; s < seg; ++s) hin = SA[s * 16 + c] * hin + SH[s * 16 + c];
    h = hin;
#pragma unroll 16
    for (int t = 0; t < 128; ++t) { const unsigned w = LAB[base + (size_t)t * DM]; h = __expf(bflo(w)) * h + bfhi(w);
        const float gt = __uint_as_float((unsigned)GATE[base + (size_t)t * DM] << 16);
        HG[base + (size_t)t * DM] = (bf16_t)(cvt_pk_bf16(h * gt, 0.f) & 0xffffu); }
    __syncthreads();
}

#define XB_TMO      128
#define XB_XCNT(j)  (256  + 64 * (j))
#define XB_XSUB(j)  (1280 + 64 * (j))
#define XB_XGEN(j)  (2304 + 64 * (j))
#define XB_TOP      3328
#define XB_TOPGEN   3392
#define XCD_BAR_WORDS 3456
#define XB_SPIN_CAP (1u << 18)
__device__ __forceinline__ unsigned xb_ld(unsigned* p)              { return __hip_atomic_load(p, __ATOMIC_RELAXED, __HIP_MEMORY_SCOPE_AGENT); }
__device__ __forceinline__ unsigned xb_add(unsigned* p, unsigned v) { return __hip_atomic_fetch_add(p, v, __ATOMIC_RELAXED, __HIP_MEMORY_SCOPE_AGENT); }
__device__ __forceinline__ unsigned xb_xcc_id() { return (unsigned)__builtin_amdgcn_s_getreg((3 << 11) | 20) & 0xFu; }
#define XB_SPIN(cond, bar) do { unsigned _sp = 0; while (cond) { __builtin_amdgcn_s_sleep(1); \
    if ((++_sp & 255u) == 0u) { if (xb_ld(&(bar)[XB_TMO])) break; if (_sp > XB_SPIN_CAP) { atomicAdd(&(bar)[XB_TMO], 1u); break; } } } } while (0)
struct XcdBarrier { unsigned* bar; unsigned x; volatile LAS unsigned* st; };
__device__ __forceinline__ void xcd_barrier_complete(unsigned* bar, unsigned x, unsigned& nloc, unsigned& nx) {
    const unsigned G = gridDim.x * gridDim.y * gridDim.z;
    unsigned sum, cnt, mine, sp = 0u;
    for (;;) {
        sum = 0u; cnt = 0u; mine = 0u;
#pragma unroll
        for (unsigned j = 0; j < 16; ++j) { const unsigned c = xb_ld(&bar[XB_XCNT(j)]); sum += c; cnt += (c > 0u) ? 1u : 0u; mine = (j == x) ? c : mine; }
        if (sum == G) break;
        __builtin_amdgcn_s_sleep(1);
        if ((++sp & 255u) == 0u) { if (xb_ld(&bar[XB_TMO])) break; if (sp > XB_SPIN_CAP) { atomicAdd(&bar[XB_TMO], 1u); break; } }
    }
    nloc = mine > 0u ? mine : 1u; nx = cnt > 0u ? cnt : 1u;
}
__device__ __forceinline__ void xcd_barrier(const XcdBarrier& b, int tid_) {
    asm volatile("s_waitcnt vmcnt(0)" ::: "memory");
    __syncthreads();
    if (tid_ == 0) {
        unsigned* bar = b.bar;
        __builtin_amdgcn_s_waitcnt(0);
        unsigned nloc = b.st[0], nx = b.st[1];
        if (nloc == 0u) { xcd_barrier_complete(bar, b.x, nloc, nx); b.st[0] = nloc; b.st[1] = nx; }
        const unsigned old = xb_add(&bar[XB_XSUB(b.x)], 1u);
        const unsigned gen = old / nloc;
        if (old + 1u == (gen + 1u) * nloc) {
            __builtin_amdgcn_fence(__ATOMIC_RELEASE, "agent");
            asm volatile("s_waitcnt vmcnt(0)" ::: "memory");
            const unsigned og = xb_add(&bar[XB_TOP], 1u);
            const unsigned tg = og / nx;
            if (og + 1u == (tg + 1u) * nx) xb_add(&bar[XB_TOPGEN], 1u);
            else XB_SPIN(xb_ld(&bar[XB_TOPGEN]) == tg, bar);
            __builtin_amdgcn_fence(__ATOMIC_ACQUIRE, "agent");
            xb_add(&bar[XB_XGEN(b.x)], 1u);
            asm volatile("s_waitcnt vmcnt(0)" ::: "memory");
        } else {
            XB_SPIN(xb_ld(&bar[XB_XGEN(b.x)]) == gen, bar);
            __builtin_amdgcn_fence(__ATOMIC_ACQUIRE, "agent");
            asm volatile("s_waitcnt vmcnt(0)" ::: "memory");
        }
    }
    __syncthreads();
}

typedef __attribute__((address_space(4))) const Params CParams;
#define KP() ({ CParams* q_ = pp; asm volatile("" : "+s"(q_)); q_; })
#define PIN(i) (KP()->in[i])
#define ws (KP()->ws)
#define XRES (KP()->out)
#define H ((bf16_t*)(ws + WS_H))
#define P ((bf16_t*)(ws + WS_P))
#define YMIX ((float*)(ws + WS_YMIX))
#define ACT ((bf16_t*)(ws + WS_ACT))
#define tid ({ int t_ = wave_s * 64 + (int)__builtin_amdgcn_mbcnt_hi(~0u, __builtin_amdgcn_mbcnt_lo(~0u, 0u)); asm volatile("" : "+v"(t_)); t_; })
#define lane (tid & 63)
#define wid (__builtin_amdgcn_readfirstlane(tid >> 6))
#define gw (bid * NWAVES + wid)
#define gt (bid * NTHREADS + tid)
#define GBAR() do { XcdBarrier xb_; xb_.bar = (unsigned*)(ws + WS_BAR); xb_.x = xcc; xb_.st = (volatile LAS unsigned*)(lds + STAGE_BYTES); xcd_barrier(xb_, tid); } while (0)

template <int layer>
__device__ __forceinline__ void layer_body(CParams* pp, const int wave_s, LAS unsigned char* lds, const unsigned xcc) {
    const int G = gridDim.x, bid = blockIdx.x;
    const int NGW = G * NWAVES, NGT = G * NTHREADS;
        const int li = layer >> 1;
        if ((layer & 1) == 0) {
            const float* mu = PIN(2) + (size_t)li * 3360;
            { Gemm g{H, (const bf16_t*)(ws + WS_EVIN + li * SZ_EVIN), DM, DM, 0, 0}; StaticOrder S; S.init(MTOK, EVIN_NP, G, bid);
              EpiBf16 E{P, EVIN_NP}; gemm_phase<EpiBf16>(lds, g, S, E, tid); }
            GBAR();
            {
                bf16_t* LRA = (bf16_t*)(ws + WS_LRACT);
                for (int i = gt; i < MTOK * LRK; i += NGT) {
                    const int m = i / LRK, j = i % LRK; float v = 0.f;
                    if (j < 288) { const int col = 4096 + j; const float z = __uint_as_float((unsigned)P[(size_t)m * EVIN_NP + col] << 16);
                        const float zp = (m & (TSEQ - 1)) ? __uint_as_float((unsigned)P[(size_t)(m - 1) * EVIN_NP + col] << 16) : 0.f;
                        const float zz = z + (zp - z) * mu[col - 1024];
                        v = (j < 64) ? (2.0f * sigm(2.0f * zz) - 1.0f) : ((j < 128) ? zz : sigm(zz)); }
                    LRA[i] = (bf16_t)(cvt_pk_bf16(v, 0.f) & 0xffffu);
                }
            }
            GBAR();
            { Gemm g{(const bf16_t*)(ws + WS_LRACT), (const bf16_t*)(ws + WS_LR + li * SZ_LR), LRK, LRK, 0, 0}; StaticOrder S; S.init(MTOK, 3072, G, bid);
              EpiLR E{(float*)(ws + WS_DEC), (bf16_t*)(ws + WS_AB), (bf16_t*)(ws + WS_GB), PIN(12) + li * 1024, PIN(14) + li * 1024}; gemm_phase<EpiLR>(lds, g, S, E, tid); }
            GBAR();
            for (int wi = bid; wi < 256; wi += G) {
                if (wi < 128) rwkv_scan(lds, wi, P, (const float*)(ws + WS_DEC), (const bf16_t*)(ws + WS_AB), (float*)(ws + WS_YRAW), mu, PIN(17) + li * 1024, PIN(18) + li * 1024, tid);
                else s5_scan(lds, wi - 128, P, (bf16_t*)(ws + WS_Y5), PIN(3) + li * 4096, PIN(4) + li * 4096, PIN(5) + li * 64,
                             PIN(6) + (size_t)li * 65536, PIN(7) + (size_t)li * 65536, PIN(8) + (size_t)li * 65536, PIN(9) + (size_t)li * 65536, PIN(10) + li * 1024, tid);
                __syncthreads();
            }
            GBAR();
            {
                Gemm g{(const bf16_t*)(ws + WS_Y5), (const bf16_t*)(ws + WS_GLU + li * SZ_GLU), 1024, 1024, 0, 0}; StaticOrder S; S.init(MTOK, 1024, G, bid);
                EpiGLU E{(const bf16_t*)(ws + WS_Y5), (bf16_t*)(ws + WS_YCAT)}; gemm_phase<EpiGLU>(lds, g, S, E, tid);
                if (bid >= 128 || G < 256) {
                    const int nb = (G < 256) ? G : (G - 128), b0 = (G < 256) ? bid : (bid - 128);
                    rwkv_post(b0 * NTHREADS + tid, nb * NTHREADS, (const float*)(ws + WS_YRAW), P, (const bf16_t*)(ws + WS_AB), (const bf16_t*)(ws + WS_GB), (bf16_t*)(ws + WS_YCAT),
                              mu, PIN(18) + li * 1024, PIN(19) + li * 1024, PIN(20) + li * 1024, PIN(21) + li * 1024);
                }
            }
            GBAR();
            { Gemm g{(const bf16_t*)(ws + WS_YCAT), (const bf16_t*)(ws + WS_EVOUT + li * SZ_SQ), DM, DM, 0, 0}; StaticOrder S; S.init(MTOK, DM, G, bid);
              EpiF32 E{YMIX, DM}; gemm_phase<EpiF32>(lds, g, S, E, tid); }
            GBAR();
        } else {
            bf16_t* GATE = (bf16_t*)(ws + WS_GATE); bf16_t* XB = (bf16_t*)(ws + WS_XB); bf16_t* XC = (bf16_t*)(ws + WS_XC);
            { Gemm g{H, (const bf16_t*)(ws + WS_ODIN + li * SZ_ODIN), DM, DM, 0, 0}; StaticOrder S; S.init(MTOK, 4096, G, bid);
              EpiOddIn E{GATE, XB}; gemm_phase<EpiOddIn>(lds, g, S, E, tid); }
            GBAR();
            {
                const float* cw = PIN(24) + (size_t)li * 4 * DM; const float* cb = PIN(25) + (size_t)li * DM;
                for (int i = gt; i < MTOK * (DM / 8); i += NGT) {
                    const int m = i >> 8, c8 = (i & 255) * 8, t = m & (TSEQ - 1);
                    float acc[8];
#pragma unroll
                    for (int j = 0; j < 8; ++j) acc[j] = cb[c8 + j];
#pragma unroll
                    for (int q = 0; q < 4; ++q) {
                        if (t - 3 + q >= 0) { const u32x4 xw = *(const u32x4*)(XB + (size_t)(m - 3 + q) * DM + c8); float xv[8]; unpack8(xw, xv);
#pragma unroll
                            for (int j = 0; j < 8; ++j) acc[j] += cw[q * DM + c8 + j] * xv[j]; }
                    }
                    *(u32x4*)(XC + (size_t)m * DM + c8) = pack8(acc);
                }
            }
            GBAR();
            { Gemm g{XC, (const bf16_t*)(ws + WS_GATES + li * SZ_GATES), DM, 256, 1, 256}; StaticOrder S; S.init(MTOK, 4096, G, bid);
              EpiGates E{XC, (unsigned*)(ws + WS_AA), PIN(27) + li * DM, PIN(29) + li * DM, PIN(30) + li * DM}; gemm_phase<EpiGates>(lds, g, S, E, tid); }
            GBAR();
            for (int wi = bid; wi < 256; wi += G) lru_scan(lds, wi, (const unsigned*)(ws + WS_AA), GATE, XB  , tid);
            GBAR();
            { Gemm g{XB  , (const bf16_t*)(ws + WS_ODOUT + li * SZ_SQ), DM, DM, 0, 0}; StaticOrder S; S.init(MTOK, DM, G, bid);
              EpiF32 E{YMIX, DM}; gemm_phase<EpiF32>(lds, g, S, E, tid); }
            GBAR();
        }
        norm_rows(YMIX, XRES, XRES, PIN(36) + layer * DM, PIN(37) + layer * DM, H, gw, NGW, lane);
        GBAR();
        { Gemm g{H, (const bf16_t*)(ws + WS_GU + layer * SZ_GU), DM, DM, 0, 0}; StaticOrder S; S.init(MTOK, 2 * DFF, G, bid);
          EpiGU E{ACT}; gemm_phase<EpiGU>(lds, g, S, E, tid); }
        GBAR();
        { Gemm g{ACT, (const bf16_t*)(ws + WS_DN + layer * SZ_DN), DFF, DFF, 0, 0}; StaticOrder S; S.init(MTOK, DM, G, bid);
          EpiF32 E{YMIX, DM}; gemm_phase<EpiF32>(lds, g, S, E, tid); }
        GBAR();
        norm_rows(YMIX, XRES, XRES, PIN(38) + layer * DM, (layer < 3) ? (PIN(35) + (layer + 1) * DM) : nullptr, H, gw, NGW, lane);
        if (layer < 3) GBAR();
}

__global__ void __launch_bounds__(NTHREADS) mega_fwd(Params p) {
    extern __shared__ __attribute__((aligned(16))) unsigned char lds_raw[];
    LAS unsigned char* lds = (LAS unsigned char*)lds_raw;
    cg::grid_group grid = cg::this_grid();
    if (threadIdx.x < 16) ((LAS unsigned*)(lds + STAGE_BYTES))[threadIdx.x] = 0u;
    __syncthreads();
    const unsigned xcc = xb_xcc_id();
    CParams* pp = (CParams*)__builtin_amdgcn_kernarg_segment_ptr();
    if (threadIdx.x == 0) (void)xb_add(&((unsigned*)(ws + WS_BAR))[XB_XCNT(xcc)], 1u);
    const int wave_s = __builtin_amdgcn_readfirstlane(threadIdx.x >> 6);
    const int G = gridDim.x, bid = blockIdx.x;
    const int NGW = G * NWAVES, NGT = G * NTHREADS;

    {
        LAS float* scr = (LAS float*)(lds + wid * 8448);
        for (int e = 0; e < 2; ++e) {
            bf16_t* wevin = (bf16_t*)(ws + WS_EVIN + e * SZ_EVIN);
            TR_JOB(PIN(1) + (size_t)e * DM * EVIN_N, EVIN_N, DM, EVIN_N, wevin, DM, nl);
            for (int i = gt; i < (EVIN_NP - EVIN_N) * DM / 8; i += NGT) *(u32x4*)(wevin + (size_t)EVIN_N * DM + (size_t)i * 8) = (u32x4){0u, 0u, 0u, 0u};
            TR_JOB(PIN(11) + (size_t)e * 1024 * 1024, 1024, 1024, 1024, (bf16_t*)(ws + WS_GLU + e * SZ_GLU), 1024, nl);
            TR_JOB(PIN(22) + (size_t)e * DM * DM, DM, DM, DM, (bf16_t*)(ws + WS_EVOUT + e * SZ_SQ), DM, nl);
            {
                bf16_t* wlr = (bf16_t*)(ws + WS_LR + e * SZ_LR);
                const float* w2 = PIN(13) + (size_t)e * 64 * 1024; const float* a2 = PIN(15) + (size_t)e * 64 * 1024; const float* g2 = PIN(16) + (size_t)e * 160 * 1024;
                for (int i = gt; i < 3072 * (LRK / 8); i += NGT) {
                    const int n = i / (LRK / 8), k8 = (i % (LRK / 8)) * 8, type = n >> 10, nn = n & 1023;
                    float o[8];
#pragma unroll
                    for (int j = 0; j < 8; ++j) { const int k = k8 + j; float v = 0.f;
                        if (type == 0) { if (k < 64) v = w2[(size_t)k * 1024 + nn]; }
                        else if (type == 1) { if (k >= 64 && k < 128) v = a2[(size_t)(k - 64) * 1024 + nn]; }
                        else { if (k >= 128 && k < 288) v = g2[(size_t)(k - 128) * 1024 + nn]; }
                        o[j] = v; }
                    *(u32x4*)(wlr + (size_t)n * LRK + k8) = pack8(o);
                }
            }
        }
        for (int o = 0; o < 2; ++o) {
            TR_JOB(PIN(23) + (size_t)o * DM * 4096, 4096, DM, 4096, (bf16_t*)(ws + WS_ODIN + o * SZ_ODIN), DM, nl);
            TR_JOB(PIN(31) + (size_t)o * DM * DM, DM, DM, DM, (bf16_t*)(ws + WS_ODOUT + o * SZ_SQ), DM, nl);
            bf16_t* wg = (bf16_t*)(ws + WS_GATES + o * SZ_GATES);
            for (int it = gw; it < 16 * 32; it += NGW) {
                const int job = it >> 5, sub = it & 31, blk = job >> 1, ri = job & 1, kb = sub >> 3, nl = (sub & 7) * 32;
                const float* W = (ri ? PIN(28) : PIN(26)) + (size_t)(o * 8 + blk) * 65536;
                tr_item(W, 256, kb * 64, nl, wg, 256, (2 * blk + (nl >> 7)) * 256 + ri * 128 + (nl & 127), kb * 64, scr, lane);
            }
        }
        for (int l = 0; l < 4; ++l) {
            bf16_t* wgu = (bf16_t*)(ws + WS_GU + l * SZ_GU);
            TR_JOB(PIN(32) + (size_t)l * DM * DFF, DFF, DM, DFF, wgu, DM, (nl >> 7) * 256 + (nl & 127));
            TR_JOB(PIN(33) + (size_t)l * DM * DFF, DFF, DM, DFF, wgu, DM, (nl >> 7) * 256 + 128 + (nl & 127));
            TR_JOB(PIN(34) + (size_t)l * DFF * DM, DM, DFF, DM, (bf16_t*)(ws + WS_DN + l * SZ_DN), DFF, nl);
        }
        norm_rows(nullptr, PIN(0), XRES, nullptr, PIN(35), H, gw, NGW, lane);
    }
    grid.sync();

    layer_body<0>(pp, wave_s, lds, xcc);
    layer_body<1>(pp, wave_s, lds, xcc);
    layer_body<2>(pp, wave_s, lds, xcc);
    layer_body<3>(pp, wave_s, lds, xcc);
}

#undef KP
#undef PIN
#undef ws
#undef XRES
#undef H
#undef P
#undef YMIX
#undef ACT
#undef tid
#undef lane
#undef wid
#undef gw
#undef gt
#undef GBAR

extern "C" void kernel_launch(void* const* d_in, const int* in_sizes, int n_in, void* d_out, int out_size, void* d_ws, size_t ws_size, hipStream_t stream) {
    static int grid = 0;
    if (grid == 0) {
        if (n_in != 39 || out_size != MTOK * DM || ws_size < WS_END) { fprintf(stderr, "kernel_launch: unexpected shapes (n_in %d out %d ws %zu need %zu)\n", n_in, out_size, ws_size, (size_t)WS_END); grid = -1; return; }
        int dev = 0, cus = 0, per_cu = 0;
        (void)hipGetDevice(&dev);
        (void)hipDeviceGetAttribute(&cus, hipDeviceAttributeMultiprocessorCount, dev);
        if (hipFuncSetAttribute((const void*)mega_fwd, hipFuncAttributeMaxDynamicSharedMemorySize, LDS_BYTES) != hipSuccess) { fprintf(stderr, "kernel_launch: hipFuncSetAttribute failed\n"); grid = -1; return; }
        if (hipOccupancyMaxActiveBlocksPerMultiprocessor(&per_cu, (const void*)mega_fwd, NTHREADS, LDS_BYTES) != hipSuccess || per_cu < 1) { fprintf(stderr, "kernel_launch: occupancy query gave %d\n", per_cu); per_cu = 1; }
        (void)hipGetLastError();
        grid = cus * 1;
    }
    if (grid < 0) return;
    if (hipMemsetAsync((char*)d_ws + WS_BAR, 0, 16384, stream) != hipSuccess) { fprintf(stderr, "kernel_launch: memset failed\n"); return; }
    Params p{};
    for (int i = 0; i < 39; ++i) p.in[i] = (const float*)d_in[i];
    p.out = (float*)d_out; p.ws = (unsigned char*)d_ws;
    void* args[] = {&p};
    hipError_t e = hipLaunchCooperativeKernel((const void*)mega_fwd, dim3(grid), dim3(NTHREADS), args, LDS_BYTES, stream);
    if (e != hipSuccess) fprintf(stderr, "cooperative launch failed: %s (grid %d)\n", hipGetErrorString(e), grid);
}
```
